# Optimizing an MI355X kernel written in HIP

```python
import math
import jax, jax.numpy as jnp
from jax import lax
import numpy as np

D_MODEL = 2048
BATCH = 8
SEQ = 2048
DEPTH = 4

HEAD_DIM = 128
A_PATTERNS = ((128, 1), (512, 4), (2048, 16))
A_GROUPS = len(A_PATTERNS)
A_HEADS_PER_GROUP = 4
A_HEADS = A_GROUPS * A_HEADS_PER_GROUP
B_HEADS = 8
N_A = 3 * A_HEADS * HEAD_DIM
N_B = 3 * B_HEADS * HEAD_DIM
N_IN = N_A + N_B + B_HEADS + 2 * D_MODEL
A_OUT = A_HEADS_PER_GROUP * HEAD_DIM
B_OUT = B_HEADS * HEAD_DIM
N_BUCKETS = 32
REL_MAX_DIST = 2048
D_FF = 5632
CONV_WIDTH = 3
Q_BLOCK = 128
EPS = 1e-6
NEG = -1e30

kernel_name = "hybrid_gated_dilated_fox_convffn"


def rms_norm(x, g):
    xf = x.astype(jnp.float32)
    y = xf * lax.rsqrt(jnp.mean(xf * xf, axis=-1, keepdims=True) + EPS)
    return (y * g.astype(jnp.float32)).astype(x.dtype)


def rel_bucket(dist):
    max_exact = N_BUCKETS // 2
    nf = jnp.maximum(dist, 1).astype(jnp.float32)
    large = max_exact + (jnp.log(nf / max_exact) / math.log(REL_MAX_DIST / max_exact)
                         * (N_BUCKETS - max_exact)).astype(jnp.int32)
    large = jnp.minimum(large, N_BUCKETS - 1)
    return jnp.where(dist < max_exact, dist, large)


def dilated_group(q, k, v, bias_table, window, dilation):
    b, t, h, hd = q.shape
    length = t // dilation
    span = window // dilation
    qb = min(Q_BLOCK, length)
    n_prev = -(-span // qb)
    nb = -(-length // qb)
    lp = nb * qb

    def to_strided(a):
        return a.reshape(b, length, dilation, h, hd).transpose(0, 2, 3, 1, 4)

    qs, ks, vs = to_strided(q), to_strided(k), to_strided(v)
    qs = jnp.pad(qs, [(0, 0)] * 3 + [(0, lp - length), (0, 0)]).reshape(b, dilation, h, nb, qb, hd)
    pad_kv = [(0, 0)] * 3 + [(n_prev * qb, lp - length), (0, 0)]
    ks = jnp.pad(ks, pad_kv).reshape(b, dilation, h, nb + n_prev, qb, hd)
    vs = jnp.pad(vs, pad_kv).reshape(b, dilation, h, nb + n_prev, qb, hd)
    kw = jnp.concatenate([ks[:, :, :, j:j + nb] for j in range(n_prev + 1)], axis=4)
    vw = jnp.concatenate([vs[:, :, :, j:j + nb] for j in range(n_prev + 1)], axis=4)
    kwidth = (n_prev + 1) * qb

    delta = jnp.arange(qb)[:, None] + n_prev * qb - jnp.arange(kwidth)[None, :]
    key_pos = (jnp.arange(nb)[:, None] - n_prev) * qb + jnp.arange(kwidth)[None, :]
    valid = ((delta >= 0) & (delta <= span))[None] & (key_pos >= 0)[:, None, :]
    bias = bias_table[rel_bucket(jnp.maximum(delta, 0) * dilation)].transpose(2, 0, 1)

    s = jnp.einsum('brhnqd,brhnkd->brhnqk', qs, kw).astype(jnp.float32) * (HEAD_DIM ** -0.5)
    s = jnp.where(valid, s + bias[:, None].astype(jnp.float32), NEG)
    m = jnp.max(s, axis=-1, keepdims=True)
    p = jnp.exp(s - m)
    l = jnp.sum(p, axis=-1)
    o = jnp.einsum('brhnqk,brhnkd->brhnqd', p.astype(vw.dtype), vw).astype(jnp.float32) / l[..., None]

    o = o.reshape(b, dilation, h, lp, hd)[:, :, :, :length].transpose(0, 3, 1, 2, 4).reshape(b, t, h, hd)
    m = m[..., 0].reshape(b, dilation, h, lp)[..., :length].transpose(0, 3, 1, 2).reshape(b, t, h)
    l = l.reshape(b, dilation, h, lp)[..., :length].transpose(0, 3, 1, 2).reshape(b, t, h)
    return o, m, l


def dilated_mixture(a_qkv, rel_bias):
    outs, maxes, dens = [], [], []
    for gi, (window, dilation) in enumerate(A_PATTERNS):
        table = rel_bias[:, gi * A_HEADS_PER_GROUP:(gi + 1) * A_HEADS_PER_GROUP]
        o, m, l = dilated_group(a_qkv[:, :, 0, gi], a_qkv[:, :, 1, gi], a_qkv[:, :, 2, gi],
                                table, window, dilation)
        outs.append(o); maxes.append(m); dens.append(l)
    o = jnp.stack(outs)
    m = jnp.stack(maxes)
    l = jnp.stack(dens)
    w = l * jnp.exp(m - jnp.max(m, axis=0, keepdims=True))
    y = jnp.sum(w[..., None] * o, axis=0) / jnp.sum(w, axis=0)[..., None]
    b, t = y.shape[:2]
    return y.reshape(b, t, A_OUT)


def forgetting_attention(q, k, v, log_f):
    b, t, h, hd = q.shape
    nb = t // Q_BLOCK
    c = jnp.cumsum(log_f.astype(jnp.float32), axis=1).transpose(0, 2, 1)
    kt = k.transpose(0, 2, 1, 3)
    vt = v.transpose(0, 2, 1, 3)
    qblk = q.reshape(b, nb, Q_BLOCK, h, hd).transpose(1, 0, 3, 2, 4)
    cblk = c.reshape(b, h, nb, Q_BLOCK).transpose(2, 0, 1, 3)
    kpos = jnp.arange(t)

    def one_block(args):
        qi, ci, i = args
        s = jnp.einsum('bhqd,bhkd->bhqk', qi, kt).astype(jnp.float32) * (HEAD_DIM ** -0.5)
        s = s + ci[..., None] - c[:, :, None, :]
        qpos = i * Q_BLOCK + jnp.arange(Q_BLOCK)
        s = jnp.where(kpos[None, :] <= qpos[:, None], s, NEG)
        p = jax.nn.softmax(s, axis=-1)
        return jnp.einsum('bhqk,bhkd->bhqd', p.astype(vt.dtype), vt)

    o = lax.map(one_block, (qblk, cblk, jnp.arange(nb)))
    return o.transpose(1, 0, 3, 2, 4).reshape(b, t, h * hd)


def conv_ffn(h, w_up, conv_w, conv_b, w_down):
    t = h.shape[1]
    u = h @ w_up
    up = jnp.pad(u, ((0, 0), (CONV_WIDTH - 1, 0), (0, 0)))
    uc = sum(conv_w[j] * up[:, j:j + t] for j in range(CONV_WIDTH)) + conv_b
    gate, val = uc[..., :D_FF], uc[..., D_FF:]
    return (jax.nn.gelu(gate, approximate=True) * val) @ w_down


def setup_inputs(seed: int = 0) -> dict:
    key = jax.random.key(seed)
    ks = jax.random.split(key, 16)
    f32 = jnp.float32
    nrm = lambda k, shape, scale: jax.random.normal(k, shape, f32) * scale
    gain = lambda k: 1.0 + 0.05 * jax.random.normal(k, (DEPTH, D_MODEL), f32)
    return {
        "x": jax.random.normal(ks[0], (BATCH, SEQ, D_MODEL), f32),
        "rel_bias": nrm(ks[1], (N_BUCKETS, A_HEADS), 0.5),
        "w_in": nrm(ks[2], (DEPTH, D_MODEL, N_IN), D_MODEL ** -0.5),
        "b_f": 3.0 + 0.5 * jax.random.normal(ks[3], (DEPTH, B_HEADS), f32),
        "w_pa": nrm(ks[4], (DEPTH, A_OUT, D_MODEL), A_OUT ** -0.5),
        "w_pb": nrm(ks[5], (DEPTH, B_OUT, D_MODEL), B_OUT ** -0.5),
        "w_o": nrm(ks[6], (DEPTH, D_MODEL, D_MODEL), D_MODEL ** -0.5),
        "w_up": nrm(ks[7], (DEPTH, D_MODEL, 2 * D_FF), D_MODEL ** -0.5),
        "conv_w": nrm(ks[8], (DEPTH, CONV_WIDTH, 2 * D_FF), CONV_WIDTH ** -0.5),
        "conv_b": nrm(ks[9], (DEPTH, 2 * D_FF), 0.02),
        "w_down": nrm(ks[10], (DEPTH, D_FF, D_MODEL), D_FF ** -0.5),
        "g_mix_pre": gain(ks[11]),
        "g_mix_post": gain(ks[12]),
        "g_ffn_pre": gain(ks[13]),
        "g_ffn_post": gain(ks[14]),
    }


def reference(x, rel_bias, w_in, b_f, w_pa, w_pb, w_o, w_up, conv_w, conv_b, w_down,
              g_mix_pre, g_mix_post, g_ffn_pre, g_ffn_post):
    b, t, _ = x.shape
    for layer in range(DEPTH):
        h = rms_norm(x, g_mix_pre[layer])
        proj = h @ w_in[layer]
        a_qkv = proj[..., :N_A].reshape(b, t, 3, A_GROUPS, A_HEADS_PER_GROUP, HEAD_DIM)
        off = N_A
        b_qkv = proj[..., off:off + N_B].reshape(b, t, 3, B_HEADS, HEAD_DIM)
        off += N_B
        f_logit = proj[..., off:off + B_HEADS]
        off += B_HEADS
        gates = jax.nn.sigmoid(proj[..., off:].astype(jnp.float32)).reshape(b, t, 2, D_MODEL)

        y_a = dilated_mixture(a_qkv, rel_bias).astype(x.dtype)
        log_f = jax.nn.log_sigmoid((f_logit + b_f[layer]).astype(jnp.float32))
        y_b = forgetting_attention(b_qkv[:, :, 0], b_qkv[:, :, 1], b_qkv[:, :, 2], log_f)

        merged = (gates[:, :, 0] * (y_a @ w_pa[layer]).astype(jnp.float32)
                  + gates[:, :, 1] * (y_b @ w_pb[layer]).astype(jnp.float32)).astype(x.dtype)
        x = x + rms_norm(merged @ w_o[layer], g_mix_post[layer])

        h = rms_norm(x, g_ffn_pre[layer])
        y = conv_ffn(h, w_up[layer], conv_w[layer], conv_b[layer], w_down[layer])
        x = x + rms_norm(y, g_ffn_post[layer])
    return x
```

```cpp
#include <hip/hip_runtime.h>
#include <cstdio>
#include <cstdint>

#ifndef FAST_GEMM
#define FAST_GEMM 1
#endif
#ifndef FAST_ATTN
#define FAST_ATTN 1
#endif
#ifndef GEMM_ALIGN
#define GEMM_ALIGN true
#endif
#ifndef MID_B
#define MID_B 4
#endif
#ifndef FIX_LOCAL
#define FIX_LOCAL 1
#endif
#ifndef BATCH_GROUPS
#define BATCH_GROUPS 1
#endif
#ifndef LATE_CONVERT
#define LATE_CONVERT 1
#endif
#ifndef CV_WGS
#define CV_WGS 8
#endif
#ifndef NOREL
#define NOREL 1
#endif
#ifndef LATE0
#define LATE0 1
#endif
#ifndef GEMM_SP2
#define GEMM_SP2 true
#endif
#ifndef DUP_SITE
#define DUP_SITE -1
#endif
#ifndef ONE_LAUNCH
#define ONE_LAUNCH 1
#endif

#define GAS __attribute__((address_space(1)))
#define LAS __attribute__((address_space(3)))
typedef unsigned short bf16_t;
typedef short bf16x8 __attribute__((ext_vector_type(8)));
typedef float f32x4 __attribute__((ext_vector_type(4)));
typedef float f32x2 __attribute__((ext_vector_type(2)));
typedef unsigned u32x4 __attribute__((ext_vector_type(4)));
typedef unsigned u32x2 __attribute__((ext_vector_type(2)));

constexpr int BATCH = 8, SEQ = 2048, DM = 2048, DEPTH = 4, HD = 128;
constexpr int M = BATCH * SEQ;
constexpr int N_A = 4608, N_QKV = 7680, N_IN = 11784, N_INP = 12032, N_G = 4096;
constexpr int N_P1 = N_QKV + 256;
constexpr float H8_SCALE = 16.f, W8_SCALE = 512.f;
constexpr int YAB_W = 1536;
constexpr int DFF = 5632, N_UP = 2 * DFF;
constexpr float EPS = 1e-6f;
constexpr float LOG2E = 1.4426950408889634f;
constexpr float QSCALE = 0.08838834764831845f * LOG2E;
constexpr int NWAVES = 8;

constexpr size_t MiB = 1u << 20;
constexpr size_t WS_CTL = 0, CTL_ZERO_BYTES = 1 * MiB;
constexpr size_t WS_TAB = 1 * MiB;
constexpr size_t WS_WIN = 2 * MiB,   SZ_WIN = (size_t)N_INP * DM * 2;
constexpr size_t WS_WPA = 190 * MiB, SZ_WPA = (size_t)DM * 512 * 2, SZ_WPAB = (size_t)DM * YAB_W * 2;
constexpr size_t WS_WPB = 198 * MiB, SZ_WPB = (size_t)DM * 1024 * 2;
constexpr size_t WS_WO  = 214 * MiB, SZ_WO  = (size_t)DM * DM * 2;
constexpr size_t WS_WUP = 246 * MiB, SZ_WUP = (size_t)N_UP * DM * 2;
constexpr size_t WS_WDN = 422 * MiB, SZ_WDN = (size_t)DM * DFF * 2;
constexpr size_t WS_H   = 510 * MiB;
constexpr size_t WS_ACT0 = 574 * MiB;
constexpr size_t WS_QKV = WS_ACT0, WS_PA = WS_ACT0;
constexpr size_t WS_G = WS_ACT0 + 240 * MiB;
constexpr size_t WS_MIX = WS_ACT0 + 368 * MiB;
constexpr size_t WS_LOGF = WS_ACT0 + 432 * MiB;
constexpr size_t WS_YAB = WS_ACT0 + 433 * MiB;
constexpr size_t WS_OG = WS_ACT0 + 481 * MiB;
constexpr size_t WS_ML = WS_ACT0 + 529 * MiB;
constexpr size_t WS_MERGED = WS_ACT0 + 531 * MiB;
constexpr size_t WS_U = WS_ACT0, WS_Y = WS_MERGED;
constexpr size_t WS_UH = WS_ACT0 + 595 * MiB, WS_UF = WS_ACT0 + 601 * MiB;
constexpr size_t WS_ACTV = WS_ACT0 + 607 * MiB;
constexpr size_t WS_XB = WS_ACT0 + 783 * MiB;
constexpr size_t WS_H8 = WS_XB + 64 * MiB;
constexpr size_t WS_END = WS_H8 + 32 * MiB;
static_assert(WS_QKV + (size_t)M * N_QKV * 2 <= WS_G && WS_G + (size_t)M * N_G * 2 <= WS_MIX && WS_MIX + (size_t)M * DM * 2 <= WS_LOGF && WS_LOGF + (size_t)M * 8 * 4 <= WS_YAB &&
              WS_YAB + (size_t)M * YAB_W * 2 <= WS_OG && WS_OG + (size_t)3 * M * 512 * 2 <= WS_ML && WS_ML + (size_t)3 * M * 8 * 4 <= WS_MERGED && WS_MERGED + (size_t)M * DM * 2 <= WS_UH &&
              WS_UH + (size_t)64 * 2 * N_UP * 4 <= WS_UF && WS_UF + (size_t)64 * 2 * N_UP * 4 <= WS_ACTV && WS_ACTV + (size_t)M * DFF * 2 <= WS_XB, "activation map: no overlaps");
constexpr size_t OFF_WG8 = (size_t)N_P1 * DM * 2;
static_assert(OFF_WG8 + (size_t)N_G * DM <= SZ_WIN, "gate weights fit");
static_assert(WS_WIN + 4 * SZ_WIN <= WS_WPA && WS_WPA + 4 * SZ_WPA <= WS_WPB && WS_WPB + 4 * SZ_WPB <= WS_WO && WS_WO + 4 * SZ_WO <= WS_WUP && WS_WUP + 4 * SZ_WUP <= WS_WDN && WS_WDN + 4 * SZ_WDN <= WS_H, "weights map");
static_assert(WS_H + (size_t)M * DM * 2 <= WS_ACT0 && WS_ACTV + (size_t)M * DFF * 2 <= WS_END, "act map");
constexpr int CW_BAR = 4096, CW_Q = 8192, CW_WRDY = 12288;

constexpr int RING_BYTES = 131072;
constexpr int LDSCTL_OFF = RING_BYTES, MISC_OFF = LDSCTL_OFF + 320;
constexpr int HALO_OFF = MISC_OFF + 128;
constexpr int LDS_BYTES = 147456;
static_assert(HALO_OFF % 16 == 0 && HALO_OFF + 8192 + 4096 <= LDS_BYTES, "LDS map");

__device__ __forceinline__ unsigned cvt_pk_bf16(float lo, float hi) { unsigned r; asm volatile("v_cvt_pk_bf16_f32 %0, %1, %2" : "=v"(r) : "v"(lo), "v"(hi)); return r; }
__device__ __forceinline__ float bf_lo(unsigned w) { return __uint_as_float(w << 16); }
__device__ __forceinline__ float bf_hi(unsigned w) { return __uint_as_float(w & 0xffff0000u); }
__device__ __forceinline__ float wave_sum(float v) {
#pragma unroll
    for (int o = 1; o < 64; o <<= 1) v += __shfl_xor(v, o);
    return v;
}
__device__ __forceinline__ int opaque_tid(int wv) {
    int l; asm volatile("v_mbcnt_lo_u32_b32 %0, -1, 0\n\tv_mbcnt_hi_u32_b32 %0, -1, %0" : "=v"(l));
    return wv * 64 + l; }
__device__ __forceinline__ float fast_exp2(float x) { return __builtin_amdgcn_exp2f(x); }
__device__ __forceinline__ float sigmoidf_(float x) { return __builtin_amdgcn_rcpf(1.0f + fast_exp2(-x * LOG2E)); }
__device__ __forceinline__ int t5_bucket(int dist) {
    if (dist < 16) return dist;
    int b = 16;
    b += (dist >= 22); b += (dist >= 30); b += (dist >= 40); b += (dist >= 54); b += (dist >= 73); b += (dist >= 99); b += (dist >= 134); b += (dist >= 182);
    b += (dist >= 246); b += (dist >= 332); b += (dist >= 450); b += (dist >= 609); b += (dist >= 825); b += (dist >= 1117); b += (dist >= 1513);
    return b;
}

#define XB_TMO      128
#define XB_XCNT(j)  (256  + 64 * (j))
#define XB_XSUB(j)  (1280 + 64 * (j))
#define XB_XGEN(j)  (2304 + 64 * (j))
#define XB_TOP      3328
#define XB_TOPGEN   3392
#define XCD_BAR_WORDS 3456
#define XB_SPIN_CAP (1u << 18)
__device__ __forceinline__ unsigned xb_ld(unsigned* p)              { return __hip_atomic_load(p, __ATOMIC_RELAXED, __HIP_MEMORY_SCOPE_AGENT); }
__device__ __forceinline__ unsigned xb_add(unsigned* p, unsigned v) { return __hip_atomic_fetch_add(p, v, __ATOMIC_RELAXED, __HIP_MEMORY_SCOPE_AGENT); }
__device__ __forceinline__ unsigned xb_xcc_id() { return (unsigned)__builtin_amdgcn_s_getreg((3 << 11) | 20) & 0xFu; }
#define XB_SPIN(cond, bar) do { unsigned _sp = 0; while (cond) { __builtin_amdgcn_s_sleep(1); \
    if ((++_sp & 255u) == 0u) { if (xb_ld(&(bar)[XB_TMO])) break; if (_sp > XB_SPIN_CAP) { atomicAdd(&(bar)[XB_TMO], 1u); break; } } } } while (0)
struct XcdBarrier { unsigned* bar; unsigned x; volatile LAS unsigned* st; };
__device__ __forceinline__ XcdBarrier xcd_barrier_post(unsigned* bar, volatile LAS unsigned* st) {
    XcdBarrier b; b.bar = bar; b.x = xb_xcc_id(); b.st = st;
    if (threadIdx.x == 0) st[3] = xb_add(&bar[XB_XCNT(b.x)], 1u);
    return b;
}
__device__ __forceinline__ void xcd_barrier_complete(unsigned* bar, unsigned x, unsigned& nloc, unsigned& nx, unsigned& even) {
    const unsigned G = gridDim.x * gridDim.y * gridDim.z;
    unsigned sum, cnt, mine, sp = 0u; even = 0u;
    for (;;) {
        sum = 0u; cnt = 0u; mine = 0u; unsigned ok8 = 1u;
#pragma unroll
        for (unsigned j = 0; j < 16; ++j) { const unsigned c = xb_ld(&bar[XB_XCNT(j)]); sum += c; cnt += (c > 0u) ? 1u : 0u; mine = (j == x) ? c : mine; ok8 &= (j < 8u) ? (c == 32u ? 1u : 0u) : (c == 0u ? 1u : 0u); }
        even = ok8;
        if (sum == G) break;
        __builtin_amdgcn_s_sleep(1);
        if ((++sp & 255u) == 0u) { if (xb_ld(&bar[XB_TMO])) break; if (sp > XB_SPIN_CAP) { atomicAdd(&bar[XB_TMO], 1u); break; } }
    }
    nloc = mine > 0u ? mine : 1u; nx = cnt > 0u ? cnt : 1u;
}
__device__ __forceinline__ void xcd_barrier(const XcdBarrier& b, int wv, bool local = false, bool norel = false) {
    asm volatile("s_waitcnt vmcnt(0)" ::: "memory");
    __syncthreads();
    if (opaque_tid(wv) == 0) {
        unsigned* bar = b.bar;
        __builtin_amdgcn_s_waitcnt(0);
        unsigned nloc = b.st[0], nx = b.st[1];
        if (nloc == 0u) { unsigned ev; xcd_barrier_complete(bar, b.x, nloc, nx, ev); b.st[0] = nloc; b.st[1] = nx; b.st[2] = ev; }
        const unsigned old = xb_add(&bar[XB_XSUB(b.x)], 1u);
        const unsigned gen = old / nloc;
        if (old + 1u == (gen + 1u) * nloc) {
            if (!(local && norel)) __builtin_amdgcn_fence(__ATOMIC_RELEASE, "agent");
            asm volatile("s_waitcnt vmcnt(0)" ::: "memory");
            if (!local) {
            const unsigned og = xb_add(&bar[XB_TOP], 1u);
            const unsigned tg = og / nx;
            if (og + 1u == (tg + 1u) * nx) xb_add(&bar[XB_TOPGEN], 1u);
            else XB_SPIN(xb_ld(&bar[XB_TOPGEN]) == tg, bar);
            }
            __builtin_amdgcn_fence(__ATOMIC_ACQUIRE, "agent");
            xb_add(&bar[XB_XGEN(b.x)], 1u);
            asm volatile("s_waitcnt vmcnt(0)" ::: "memory");
        } else {
            XB_SPIN(xb_ld(&bar[XB_XGEN(b.x)]) == gen, bar);
            __builtin_amdgcn_fence(__ATOMIC_ACQUIRE, "agent");
            asm volatile("s_waitcnt vmcnt(0)" ::: "memory");
        }
    }
    __syncthreads();
}

__host__ __device__ __forceinline__ int perm32(int rho) { const int n = rho >> 4, i = rho & 15; return 8 * (i >> 2) + 4 * n + (i & 3); }
struct Gemm { const bf16_t* A; int lda; const bf16_t* Bt; int ldb; int M, N, K; };

template <class Epi>
__device__ __forceinline__ void gemm_naive(const Gemm g, const Epi& E, int gw, int ngw, int lane) {
    const int fr = lane & 15, fq = lane >> 4;
    const int ntn = g.N / 64, ntm = g.M / 64;
    for (int tile = gw; tile < ntn * ntm; tile += ngw) {
        const int tm = tile / ntn, tn = tile % ntn;
        f32x4 acc[4][2][2];
#pragma unroll
        for (int m = 0; m < 4; ++m)
#pragma unroll
            for (int q = 0; q < 2; ++q)
#pragma unroll
                for (int n = 0; n < 2; ++n) acc[m][q][n] = (f32x4){0.f, 0.f, 0.f, 0.f};
        const bf16_t* ap = g.A + (size_t)(tm * 64 + fr) * g.lda + fq * 8;
        const bf16_t* bp0 = g.Bt + (size_t)(tn * 64 + perm32(fr)) * g.ldb + fq * 8;
        const bf16_t* bp1 = g.Bt + (size_t)(tn * 64 + perm32(16 + fr)) * g.ldb + fq * 8;
        for (int k0 = 0; k0 < g.K; k0 += 32) {
            bf16x8 af[4], bf[2][2];
#pragma unroll
            for (int m = 0; m < 4; ++m) af[m] = *(const bf16x8*)(ap + (size_t)(16 * m) * g.lda + k0);
#pragma unroll
            for (int q = 0; q < 2; ++q) { bf[q][0] = *(const bf16x8*)(bp0 + (size_t)(32 * q) * g.ldb + k0); bf[q][1] = *(const bf16x8*)(bp1 + (size_t)(32 * q) * g.ldb + k0); }
#pragma unroll
            for (int m = 0; m < 4; ++m)
#pragma unroll
                for (int q = 0; q < 2; ++q)
#pragma unroll
                    for (int n = 0; n < 2; ++n) acc[m][q][n] = __builtin_amdgcn_mfma_f32_16x16x32_bf16(bf[q][n], af[m], acc[m][q][n], 0, 0, 0);
        }
        const int ctile = __builtin_amdgcn_readfirstlane((tn * 64) >> 8);
#pragma unroll
        for (int m = 0; m < 4; ++m)
#pragma unroll
            for (int q = 0; q < 2; ++q) {
                const float v[8] = {acc[m][q][0][0], acc[m][q][0][1], acc[m][q][0][2], acc[m][q][0][3], acc[m][q][1][0], acc[m][q][1][1], acc[m][q][1][2], acc[m][q][1][3]};
                E(tm * 64 + 16 * m + fr, tn * 64 + 32 * q + 8 * fq, v, ctile);
            }
    }
}

namespace pg8 { struct Unit { int pm, pn; }; }
__device__ __forceinline__ void store_bf16x8(bf16_t* p, const float (&v)[8]) {
    u32x4 w; w.x = cvt_pk_bf16(v[0], v[1]); w.y = cvt_pk_bf16(v[2], v[3]); w.z = cvt_pk_bf16(v[4], v[5]); w.w = cvt_pk_bf16(v[6], v[7]);
    *(u32x4*)p = w;
}
struct EpiInProj {
    static constexpr bool TILE = false, MID = false;
    bf16_t* QKV; float* LOGF; const float* bf;
    __device__ __forceinline__ void operator()(int row, int col0, const float (&v)[8], int ctile) const {
        if (ctile < 30) {
            const bool isq = (ctile < 6) || (ctile >= 18 && ctile < 22);
            const float sc = isq ? QSCALE : 1.0f;
            const float w[8] = {v[0] * sc, v[1] * sc, v[2] * sc, v[3] * sc, v[4] * sc, v[5] * sc, v[6] * sc, v[7] * sc};
            store_bf16x8(QKV + (size_t)row * N_QKV + col0, w);
        } else if (col0 == N_QKV) {
            float w[8];
#pragma unroll
            for (int j = 0; j < 8; ++j) { const float z = v[j] + bf[j]; w[j] = fminf(z, 0.f) - log1pf(expf(-fabsf(z))); }
            *(f32x4*)(LOGF + (size_t)row * 8) = (f32x4){w[0], w[1], w[2], w[3]};
            *(f32x4*)(LOGF + (size_t)row * 8 + 4) = (f32x4){w[4], w[5], w[6], w[7]};
        }
    }
};
struct EpiGates {
    static constexpr bool TILE = true, MID = false, PRE = false;
    bf16_t* G;
    __device__ __forceinline__ void tile(const f32x4 (&acc)[2][2][4][2], const pg8::Unit& u, int wr, int wc, int fr, int fq, LAS unsigned char*) const {
        constexpr float ninv = -LOG2E / (H8_SCALE * W8_SCALE);
#pragma unroll
        for (int ai = 0; ai < 2; ++ai)
#pragma unroll
            for (int m = 0; m < 4; ++m) {
                float r[8], gb[8];
#pragma unroll
                for (int e = 0; e < 8; e += 2) {
                    const f32x2 za = (f32x2){acc[ai][0][m][e >> 2][e & 3], acc[ai][0][m][e >> 2][(e & 3) + 1]} * ninv, zb = (f32x2){acc[ai][1][m][e >> 2][e & 3], acc[ai][1][m][e >> 2][(e & 3) + 1]} * ninv;
                    const f32x2 da = (f32x2){fast_exp2(za[0]), fast_exp2(za[1])} + 1.0f, db = (f32x2){fast_exp2(zb[0]), fast_exp2(zb[1])} + 1.0f;
                    r[e] = fminf(db[0], 1e20f) * __builtin_amdgcn_rcpf(da[0]); r[e + 1] = fminf(db[1], 1e20f) * __builtin_amdgcn_rcpf(da[1]);
                    gb[e] = __builtin_amdgcn_rcpf(db[0]); gb[e + 1] = __builtin_amdgcn_rcpf(db[1]);
                }
                bf16_t* gp = G + (size_t)(u.pm * 256 + ai * 128 + wr * 64 + m * 16 + fr) * N_G + u.pn * 128 + wc * 32 + 8 * fq;
                store_bf16x8(gp, r); store_bf16x8(gp + DM, gb);
            }
    }
};
struct EpiF32 {
    static constexpr bool TILE = false, MID = false;
    float* C; int ldc;
    __device__ __forceinline__ void operator()(int row, int col0, const float (&v)[8], int) const {
        float* p = C + (size_t)row * ldc + col0;
        *(f32x4*)p = (f32x4){v[0], v[1], v[2], v[3]}; *(f32x4*)(p + 4) = (f32x4){v[4], v[5], v[6], v[7]};
    }
};
struct EpiBf16 {
    static constexpr bool TILE = false, MID = false;
    bf16_t* O; int ldc;
    __device__ __forceinline__ void operator()(int row, int col0, const float (&v)[8], int) const { store_bf16x8(O + (size_t)row * ldc + col0, v); }
};
struct EpiMerge {
    static constexpr bool TILE = false, MID = false;
    const bf16_t* PA; const bf16_t* G; bf16_t* O;
    __device__ __forceinline__ void operator()(int row, int col0, const float (&v)[8], int) const {
        const u32x4 pa = *(const u32x4*)(PA + (size_t)row * DM + col0);
        const u32x4 ga = *(const u32x4*)(G + (size_t)row * N_G + col0), gb = *(const u32x4*)(G + (size_t)row * N_G + DM + col0);
        float w[8];
#pragma unroll
        for (int e = 0; e < 4; ++e) { w[2 * e] = bf_lo(ga[e]) * bf_lo(pa[e]) + bf_lo(gb[e]) * v[2 * e]; w[2 * e + 1] = bf_hi(ga[e]) * bf_hi(pa[e]) + bf_hi(gb[e]) * v[2 * e + 1]; }
        store_bf16x8(O + (size_t)row * DM + col0, w);
    }
};

struct EpiPaPb {
    static constexpr bool TILE = true, MID = true, PRE = false; static constexpr int MID_T = 512 / 64;
    const bf16_t* G; bf16_t* O;
    __device__ __forceinline__ void mid(f32x4 (&acc)[2][2][4][2], const pg8::Unit& u, int wr, int wc, int fr, int fq) const {
        asm volatile("" : "+v"(fr), "+v"(fq));
        u32x4 rr[2][4][2];
#pragma unroll
        for (int ai = 0; ai < 2; ++ai)
#pragma unroll
            for (int m = 0; m < 4; ++m)
#pragma unroll
                for (int bj = 0; bj < 2; ++bj)
                    rr[ai][m][bj] = *(const u32x4*)(G + (size_t)(u.pm * 256 + ai * 128 + wr * 64 + m * 16 + fr) * N_G + u.pn * 256 + bj * 128 + wc * 32 + 8 * fq);
        asm volatile("s_waitcnt vmcnt(0)" ::: "memory");
#pragma unroll
        for (int ai = 0; ai < 2; ++ai)
#pragma unroll
            for (int m = 0; m < 4; ++m)
#pragma unroll
                for (int bj = 0; bj < 2; ++bj) {
                    asm volatile("" : "+v"(rr[ai][m][bj]));
#pragma unroll
                    for (int e = 0; e < 4; ++e) { acc[ai][bj][m][e >> 1][(e & 1) * 2] *= bf_lo(rr[ai][m][bj][e]); acc[ai][bj][m][e >> 1][(e & 1) * 2 + 1] *= bf_hi(rr[ai][m][bj][e]); }
                }
    }
    __device__ __forceinline__ void tile(const f32x4 (&acc)[2][2][4][2], const pg8::Unit& u, int wr, int wc, int fr, int fq, LAS unsigned char*) const {
        u32x4 gb[2][4][2];
#pragma unroll
        for (int ai = 0; ai < 2; ++ai)
#pragma unroll
            for (int m = 0; m < 4; ++m)
#pragma unroll
                for (int bj = 0; bj < 2; ++bj)
                    gb[ai][m][bj] = *(const u32x4*)(G + (size_t)(u.pm * 256 + ai * 128 + wr * 64 + m * 16 + fr) * N_G + DM + u.pn * 256 + bj * 128 + wc * 32 + 8 * fq);
        asm volatile("s_waitcnt vmcnt(0)" ::: "memory");
#pragma unroll
        for (int ai = 0; ai < 2; ++ai)
#pragma unroll
            for (int m = 0; m < 4; ++m)
#pragma unroll
                for (int bj = 0; bj < 2; ++bj) {
                    asm volatile("" : "+v"(gb[ai][m][bj]));
                    const float v[8] = {acc[ai][bj][m][0][0], acc[ai][bj][m][0][1], acc[ai][bj][m][0][2], acc[ai][bj][m][0][3], acc[ai][bj][m][1][0], acc[ai][bj][m][1][1], acc[ai][bj][m][1][2], acc[ai][bj][m][1][3]};
                    float w[8];
#pragma unroll
                    for (int e = 0; e < 4; ++e) { w[2 * e] = v[2 * e] * fmaxf(bf_lo(gb[ai][m][bj][e]), 1e-20f); w[2 * e + 1] = v[2 * e + 1] * fmaxf(bf_hi(gb[ai][m][bj][e]), 1e-20f); }
                    store_bf16x8(O + (size_t)(u.pm * 256 + ai * 128 + wr * 64 + m * 16 + fr) * DM + u.pn * 256 + bj * 128 + wc * 32 + 8 * fq, w);
                }
    }
    __device__ __forceinline__ void operator()(int row, int col0, const float (&v)[8], int) const {
        const u32x4 gb = *(const u32x4*)(G + (size_t)row * N_G + DM + col0);
        float w[8];
#pragma unroll
        for (int e = 0; e < 4; ++e) { w[2 * e] = v[2 * e] * fmaxf(bf_lo(gb[e]), 1e-20f); w[2 * e + 1] = v[2 * e + 1] * fmaxf(bf_hi(gb[e]), 1e-20f); }
        store_bf16x8(O + (size_t)row * DM + col0, w);
    }
};

namespace pg8 {
constexpr int BM = 256, BK = 64, HALF = 128, HTB = HALF * BK * 2, STAGE_BYTES = 8 * HTB, NXCD = 8, WGM = 8;
__host__ __device__ __forceinline__ int lds_byte(int r, int c) { const int st = (r >> 4) * 2 + (c >> 5), rr = r & 15, cc = c & 31, ob = rr * 64 + cc * 2; return st * 1024 + (ob ^ (((ob >> 9) & 1) << 5)); }
__host__ __device__ __forceinline__ void stage_rc(int b, int& R, int& C) { const int st = b / 1024, sb = b % 1024, swz = sb ^ (((sb >> 9) & 1) << 5); R = (st >> 1) * 16 + swz / 64; C = (st & 1) * 32 + (swz % 64) / 2; }
struct StaticOrder {
    int nM, nN, nwg, G, c, split;
    __host__ __device__ void init(int M_, int N_, int G_, int c_) { nM = M_ / BM; nN = N_ / BM; nwg = nM * nN; G = G_; c = c_; split = 0; }
    __host__ __device__ bool next(int i, Unit& u) const {
        long L;
        if (!split) { L = (long)i * G + c; if (L >= nwg) return false; }
        else {
            if (i < 3) L = (long)i * G + c; else if (c >= G / 2 && i < 5) L = 3L * G + (long)(i - 3) * (G / 2) + (c - G / 2); else return false;
        }
        int wgid = (int)L; { const int q = nwg / NXCD, r = nwg % NXCD, xcd = wgid % NXCD, off = wgid / NXCD; wgid = (xcd < r ? xcd * (q + 1) : r * (q + 1) + (xcd - r) * q) + off; }
        const int nig = WGM * nN, gid = wgid / nig, fm = gid * WGM, gsz = (nM - fm) < WGM ? (nM - fm) : WGM;
        u.pm = fm + ((wgid % nig) % gsz); u.pn = (wgid % nig) / gsz; return true;
    }
};
template <class Epi>
__device__ __forceinline__ void run_epi(const Epi& E, const f32x4 (&acc)[2][2][4][2], const Unit& u, int wr, int wc, int fr, int fq) {
#pragma unroll
    for (int ai = 0; ai < 2; ++ai)
#pragma unroll
        for (int m = 0; m < 4; ++m)
#pragma unroll
            for (int bj = 0; bj < 2; ++bj) {
                const float v[8] = {acc[ai][bj][m][0][0], acc[ai][bj][m][0][1], acc[ai][bj][m][0][2], acc[ai][bj][m][0][3], acc[ai][bj][m][1][0], acc[ai][bj][m][1][1], acc[ai][bj][m][1][2], acc[ai][bj][m][1][3]};
                E(u.pm * BM + ai * HALF + wr * 64 + m * 16 + fr, u.pn * BM + bj * HALF + wc * 32 + 8 * fq, v, u.pn);
            }
}
typedef int v8i32 __attribute__((ext_vector_type(8)));
typedef int v4i32 __attribute__((ext_vector_type(4)));
__device__ __forceinline__ v8i32 cat16(bf16x8 a, bf16x8 b) { const v4i32 x = __builtin_bit_cast(v4i32, a), y = __builtin_bit_cast(v4i32, b); return __builtin_shufflevector(x, y, 0, 1, 2, 3, 4, 5, 6, 7); }
template <class Epi, bool ALIGN_EPI = true, bool SP2 = true, bool F8 = false>
__device__ __forceinline__ void gemm_phase(LAS unsigned char* lds, const Gemm g, const StaticOrder& S, const Epi& E, int wv) {
    const int tid = opaque_tid(wv), wid = __builtin_amdgcn_readfirstlane(tid >> 6), lane = tid & 63, wr = wid >> 2, wc = wid & 3, fr = lane & 15, fq = lane >> 4;
    constexpr int ESZ = F8 ? 1 : 2; const int nt = g.K * ESZ / (BK * 2);
    unsigned voffA[2], voffB[2];
#pragma unroll
    for (int i = 0; i < 2; ++i) { int R, C; stage_rc(tid * 16 + i * 8192, R, C); const int Rb = (R & ~31) + perm32(R & 31);
        voffA[i] = (unsigned)(R * g.lda * ESZ + C * 2); voffB[i] = (unsigned)(Rb * g.ldb * ESZ + C * 2); }
    const size_t kstep = (size_t)(BK * 2);
    const size_t hstepA = (size_t)HALF * g.lda * ESZ, hstepB = (size_t)HALF * g.ldb * ESZ;
    const size_t tstepA = 2 * hstepA, tstepB = 2 * hstepB;
    const unsigned ldsw = (unsigned)wid * 1024u;
    const int aoff = lds_byte(wr * 64 + fr, fq * 8), boff = lds_byte(wc * 32 + fr, fq * 8);
#define PG8_SA(b, h) (((b) * 2 + (h)) * HTB)
#define PG8_SB(b, h) ((4 + (b) * 2 + (h)) * HTB)
#define PG8_STAGE(bufoff, gbase, voff) do { _Pragma("unroll") for (int _i = 0; _i < 2; ++_i) \
        __builtin_amdgcn_global_load_lds((const unsigned*)((const char*)(gbase) + (voff)[_i]), (LAS unsigned*)(lds + (bufoff) + ldsw + _i * 8192), 16, 0, 0); } while (0)
#define PG8_ASMRD(dst_, base_, off_) asm volatile("ds_read_b128 %0, %1 offset:%2" : "=&v"(dst_) : "v"(base_), "i"(off_) : "memory")
#define PG8_LDA(dst, b, h) do { _Pragma("unroll") for (int m = 0; m < 4; ++m) { if constexpr (F8) dst##8[m] = cat16(*(const LAS bf16x8*)(lds + PG8_SA(b, h) + aoff + m * 2048), *(const LAS bf16x8*)(lds + PG8_SA(b, h) + aoff + m * 2048 + 1024)); \
        else { const int ab_ = (int)(uintptr_t)(lds + PG8_SA(b, h) + aoff); _Pragma("unroll") for (int k = 0; k < 2; ++k) PG8_ASMRD(dst[m][k], ab_, m * 2048 + k * 1024); } } } while (0)
#define PG8_LDB(dst, b, h) do { _Pragma("unroll") for (int n = 0; n < 2; ++n) { if constexpr (F8) dst##8[n] = cat16(*(const LAS bf16x8*)(lds + PG8_SB(b, h) + boff + n * 2048), *(const LAS bf16x8*)(lds + PG8_SB(b, h) + boff + n * 2048 + 1024)); \
        else { const int bb_ = (int)(uintptr_t)(lds + PG8_SB(b, h) + boff); _Pragma("unroll") for (int k = 0; k < 2; ++k) PG8_ASMRD(dst[n][k], bb_, n * 2048 + k * 1024); } } } while (0)
#define PG8_MMA(ai, bj, At, Bt) do { __builtin_amdgcn_s_setprio(1); _Pragma("unroll") for (int m = 0; m < 4; ++m) _Pragma("unroll") for (int n = 0; n < 2; ++n) { \
        if constexpr (F8) asm volatile("v_mfma_scale_f32_16x16x128_f8f6f4 %0, %1, %2, %0, %3, %3 op_sel_hi:[0,0,0]" : "+v"(acc[ai][bj][m][n]) : "v"(Bt##8[n]), "v"(At##8[m]), "v"(sc8_));     \
        else { _Pragma("unroll") for (int k = 0; k < 2; ++k) acc[ai][bj][m][n] = __builtin_amdgcn_mfma_f32_16x16x32_bf16(Bt[n][k], At[m][k], acc[ai][bj][m][n], 0, 0, 0); } } \
        __builtin_amdgcn_s_setprio(0); } while (0)
#define PG8_WAIT_V(n) asm volatile("s_waitcnt vmcnt(" #n ")" ::: "memory")
#define PG8_WAIT_L(n) asm volatile("s_waitcnt lgkmcnt(" #n ")" ::: "memory")
#define PG8_BAR __builtin_amdgcn_s_barrier()
#define PG8_SCHED __builtin_amdgcn_sched_barrier(0)
    Unit cur, nxt; int ui = 0;
    if (!S.next(0, cur)) return;
    f32x4 acc[2][2][4][2];
#pragma unroll
    for (int a = 0; a < 2; ++a)
#pragma unroll
        for (int b = 0; b < 2; ++b)
#pragma unroll
            for (int m = 0; m < 4; ++m)
#pragma unroll
                for (int n = 0; n < 2; ++n) acc[a][b][m][n] = (f32x4){0.f, 0.f, 0.f, 0.f};
    const int sc8_ = 0x7f7f7f7f;
    bf16x8 At[4][2], B0[2][2], B1[2][2]; v8i32 At8[4], B08[2], B18[2];
    const char* cA = (const char*)g.A + (size_t)cur.pm * tstepA; const char* cB = (const char*)g.Bt + (size_t)cur.pn * tstepB;
    if constexpr (SP2) {
        PG8_STAGE(PG8_SB(0, 0), cB, voffB); PG8_STAGE(PG8_SB(0, 1), cB + hstepB, voffB); PG8_STAGE(PG8_SA(0, 0), cA, voffA); PG8_STAGE(PG8_SA(0, 1), cA + hstepA, voffA);
        if (wr == 1) PG8_BAR;
        PG8_WAIT_V(2); PG8_BAR;
        PG8_STAGE(PG8_SB(1, 0), cB + kstep, voffB); PG8_STAGE(PG8_SA(1, 0), cA + kstep, voffA); PG8_STAGE(PG8_SB(1, 1), cB + hstepB + kstep, voffB);
        PG8_WAIT_V(6); PG8_BAR;
    } else {
        PG8_STAGE(PG8_SB(0, 0), cB, voffB); PG8_STAGE(PG8_SA(0, 0), cA, voffA); PG8_STAGE(PG8_SB(0, 1), cB + hstepB, voffB); PG8_STAGE(PG8_SA(0, 1), cA + hstepA, voffA);
        if (wr == 1) PG8_BAR;
        PG8_WAIT_V(4); PG8_BAR;
        PG8_STAGE(PG8_SB(1, 0), cB + kstep, voffB); PG8_STAGE(PG8_SA(1, 0), cA + kstep, voffA); PG8_STAGE(PG8_SB(1, 1), cB + hstepB + kstep, voffB);
        PG8_WAIT_V(6); PG8_BAR;
    }
    for (;;) {
        const bool has_next = S.next(ui + 1, nxt);
        const char* nA = has_next ? (const char*)g.A + (size_t)nxt.pm * tstepA : cA; const char* nB = has_next ? (const char*)g.Bt + (size_t)nxt.pn * tstepB : cB;
        for (int t = 0; t < nt; t += 2) {
            const bool last = (t == nt - 2);
            const char* a1 = cA + (size_t)(t + 1) * kstep;
            const char* a2 = last ? nA : cA + (size_t)(t + 2) * kstep; const char* b2 = last ? nB : cB + (size_t)(t + 2) * kstep;
            const char* a3 = a2 + kstep; const char* b3 = b2 + kstep;
            if constexpr (Epi::MID) { if (t == Epi::MID_T) E.mid(acc, cur, wr, wc, fr, fq); }
            if constexpr (SP2) {
            PG8_LDB(B0, 0, 0); PG8_SCHED; PG8_LDA(At, 0, 0); PG8_SCHED; PG8_LDB(B1, 0, 1); PG8_STAGE(PG8_SA(1, 1), a1 + hstepA, voffA);
            PG8_WAIT_V(8); if (wr == 1) PG8_WAIT_L(0); else PG8_WAIT_L(4); PG8_BAR; PG8_SCHED; PG8_MMA(0, 0, At, B0); PG8_WAIT_L(0); PG8_SCHED; PG8_MMA(0, 1, At, B1); PG8_BAR; PG8_SCHED;
            PG8_LDA(At, 0, 1); PG8_STAGE(PG8_SB(0, 0), b2, voffB); PG8_STAGE(PG8_SB(0, 1), b2 + hstepB, voffB); PG8_STAGE(PG8_SA(0, 0), a2, voffA);
            PG8_WAIT_V(8); PG8_WAIT_L(0); PG8_BAR; PG8_SCHED; PG8_MMA(1, 0, At, B0); PG8_MMA(1, 1, At, B1); PG8_BAR; PG8_SCHED;
            PG8_LDB(B0, 1, 0); PG8_SCHED; PG8_LDA(At, 1, 0); PG8_SCHED; PG8_LDB(B1, 1, 1); PG8_STAGE(PG8_SA(0, 1), a2 + hstepA, voffA);
            PG8_WAIT_V(8); if (wr == 1) PG8_WAIT_L(0); else PG8_WAIT_L(4); PG8_BAR; PG8_SCHED; PG8_MMA(0, 0, At, B0); PG8_WAIT_L(0); PG8_SCHED; PG8_MMA(0, 1, At, B1); PG8_BAR; PG8_SCHED;
            PG8_LDA(At, 1, 1); PG8_STAGE(PG8_SB(1, 0), b3, voffB); PG8_STAGE(PG8_SB(1, 1), b3 + hstepB, voffB); PG8_STAGE(PG8_SA(1, 0), a3, voffA);
            PG8_WAIT_V(8); PG8_WAIT_L(0); PG8_BAR; PG8_SCHED; PG8_MMA(1, 0, At, B0); PG8_MMA(1, 1, At, B1); PG8_BAR; PG8_SCHED;
            } else {
            PG8_LDB(B0, 0, 0); PG8_SCHED; PG8_LDA(At, 0, 0); PG8_STAGE(PG8_SA(1, 1), a1 + hstepA, voffA);
            PG8_WAIT_L(8); PG8_BAR; PG8_WAIT_L(0); PG8_MMA(0, 0, At, B0); PG8_BAR; PG8_SCHED;
            PG8_LDB(B1, 0, 1); PG8_STAGE(PG8_SB(0, 0), b2, voffB);
            PG8_BAR; PG8_WAIT_L(0); PG8_MMA(0, 1, At, B1); PG8_BAR;
            PG8_LDA(At, 0, 1); PG8_STAGE(PG8_SA(0, 0), a2, voffA);
            PG8_BAR; PG8_WAIT_L(0); PG8_MMA(1, 0, At, B0); PG8_BAR; PG8_SCHED;
            PG8_STAGE(PG8_SB(0, 1), b2 + hstepB, voffB);
            PG8_WAIT_V(6); PG8_BAR; PG8_MMA(1, 1, At, B1); PG8_BAR;
            PG8_LDB(B0, 1, 0); PG8_SCHED; PG8_LDA(At, 1, 0); PG8_STAGE(PG8_SA(0, 1), a2 + hstepA, voffA);
            PG8_WAIT_L(8); PG8_BAR; PG8_WAIT_L(0); PG8_MMA(0, 0, At, B0); PG8_BAR; PG8_SCHED;
            PG8_LDB(B1, 1, 1); PG8_STAGE(PG8_SB(1, 0), b3, voffB);
            PG8_BAR; PG8_WAIT_L(0); PG8_MMA(0, 1, At, B1); PG8_BAR;
            PG8_LDA(At, 1, 1); PG8_STAGE(PG8_SA(1, 0), a3, voffA);
            PG8_BAR; PG8_WAIT_L(0); PG8_MMA(1, 0, At, B0); PG8_BAR; PG8_SCHED;
            PG8_STAGE(PG8_SB(1, 1), b3 + hstepB, voffB);
            PG8_WAIT_V(6); PG8_BAR; PG8_MMA(1, 1, At, B1); PG8_BAR;
            }
        }
        f32x4 pre_ = {0.f, 0.f, 0.f, 0.f};
        if constexpr (Epi::TILE) { if constexpr (Epi::PRE) { pre_ = E.pre(cur, wr, wc, fr, fq); PG8_SCHED; } }
        if constexpr (ALIGN_EPI) { if (wr == 0) PG8_BAR; }
        if constexpr (F8) asm volatile("s_nop 15\n\ts_nop 7" ::: "memory");
        if constexpr (Epi::TILE) { if constexpr (Epi::PRE) E.tile(acc, cur, wr, wc, fr, fq, lds + HALO_OFF, pre_); else E.tile(acc, cur, wr, wc, fr, fq, lds + HALO_OFF); } else run_epi(E, acc, cur, wr, wc, fr, fq);
        if (!has_next) break;
#pragma unroll
        for (int a = 0; a < 2; ++a)
#pragma unroll
            for (int b = 0; b < 2; ++b)
#pragma unroll
                for (int m = 0; m < 4; ++m)
#pragma unroll
                    for (int n = 0; n < 2; ++n) acc[a][b][m][n] = (f32x4){0.f, 0.f, 0.f, 0.f};
        cur = nxt; cA = nA; cB = nB; ++ui;
        if constexpr (ALIGN_EPI) { if (wr == 1) PG8_BAR; }
    }
    PG8_WAIT_V(0);
    if constexpr (!ALIGN_EPI) { if (wr == 0) PG8_BAR; }
    PG8_BAR;
#undef PG8_SA
#undef PG8_SB
#undef PG8_STAGE
#undef PG8_ASMRD
#undef PG8_LDA
#undef PG8_LDB
#undef PG8_MMA
#undef PG8_WAIT_V
#undef PG8_WAIT_L
#undef PG8_BAR
#undef PG8_SCHED
}
}

__device__ __forceinline__ float gelu_tanh(float x) {
    constexpr float K0 = -2.0f * LOG2E * 0.7978845608028654f, K1 = K0 * 0.044715f;
    return x * __builtin_amdgcn_rcpf(1.0f + fast_exp2(x * __builtin_fmaf(x * x, K1, K0))); }

template <int SH> __device__ __forceinline__ float dpp_prev(float cur, float pg) {
    const int o = __builtin_amdgcn_mov_dpp(__float_as_int(pg), 0x120 + SH, 0xf, 0xf, true);
    return __int_as_float(__builtin_amdgcn_update_dpp(o, __float_as_int(cur), 0x110 + SH, 0xf, 0xf, false));
}
struct EpiConv {
    static constexpr bool TILE = true, MID = false, PRE = true;
    const float* cw; const float* cb; bf16_t* ACT; float* UH; float* UF;
    __device__ __forceinline__ f32x4 pre(const pg8::Unit& u, int wr, int wc, int fr, int fq) const {
        f32x4 r = {0.f, 0.f, 0.f, 0.f}; const int cwt = wc * 64 + fq * 16 + fr, cwrow = cwt >> 5, cwc = (cwt & 31) * 4;
        if (wr == 0) { const int rr = cwrow & 3; r = *(const f32x4*)((rr < 3 ? cw + (size_t)rr * N_UP : cb) + (cwrow >> 2) * DFF + u.pn * 128 + cwc); }
        return r; }
    __device__ __forceinline__ void tile(const f32x4 (&acc)[2][2][4][2], const pg8::Unit& u, int wr, int wc, int fr, int fq, LAS unsigned char* halo_b, f32x4 cwreg) const {
        LAS float* halo = (LAS float*)halo_b;
        LAS float* cwl = (LAS float*)(halo_b + 8192);
        const int chl = wc * 32 + fq * 8, ch0 = u.pn * 128 + chl;
        const int cwt = wc * 64 + fq * 16 + fr, cwrow = cwt >> 5, cwc = (cwt & 31) * 4;
#pragma unroll
        for (int ai = 0; ai < 2; ++ai) {
            if (fr >= 14) { LAS float* hp = halo + ((2 * ai + wr) * 2 + (fr - 14)) * 256 + chl;
#pragma unroll
                for (int bj = 0; bj < 2; ++bj) { *(LAS f32x4*)(hp + bj * 128) = acc[ai][bj][3][0]; *(LAS f32x4*)(hp + bj * 128 + 4) = acc[ai][bj][3][1]; } }
        }
        if (wr == 0) *(LAS f32x4*)(cwl + cwrow * 128 + cwc) = cwreg;
        asm volatile("s_waitcnt lgkmcnt(0)" ::: "memory"); __builtin_amdgcn_s_barrier(); asm volatile("" ::: "memory");
#pragma unroll
        for (int ai = 0; ai < 2; ++ai) {
            const int q = 2 * ai + wr;
            unsigned outw[4][4];
#pragma unroll
            for (int ep = 0; ep < 4; ++ep) {
                const int n = ep >> 1, i0 = (ep & 1) * 2;
                const LAS float* wp = cwl + chl + 2 * ep;
                const f32x2 wg0 = *(const LAS f32x2*)wp, wg1 = *(const LAS f32x2*)(wp + 128), wg2 = *(const LAS f32x2*)(wp + 256), bg = *(const LAS f32x2*)(wp + 384);
                const f32x2 wv0 = *(const LAS f32x2*)(wp + 512), wv1 = *(const LAS f32x2*)(wp + 640), wv2 = *(const LAS f32x2*)(wp + 768), bv = *(const LAS f32x2*)(wp + 896);
                float pga = 0.f, pgb = 0.f, pva = 0.f, pvb = 0.f;
                if (q > 0 && fr >= 14) { const LAS float* hp = halo + ((q - 1) * 2 + (fr - 14)) * 256 + chl + 2 * ep;
                    const f32x2 hg = *(const LAS f32x2*)hp, hv = *(const LAS f32x2*)(hp + 128); pga = hg[0]; pgb = hg[1]; pva = hv[0]; pvb = hv[1]; }
#pragma unroll
                for (int m = 0; m < 4; ++m) {
                    const float ga = acc[ai][0][m][n][i0], gb = acc[ai][0][m][n][i0 + 1], va = acc[ai][1][m][n][i0], vb = acc[ai][1][m][n][i0 + 1];
                    const f32x2 g0 = {ga, gb}, g1 = {dpp_prev<1>(ga, pga), dpp_prev<1>(gb, pgb)}, g2 = {dpp_prev<2>(ga, pga), dpp_prev<2>(gb, pgb)};
                    const f32x2 v0 = {va, vb}, v1 = {dpp_prev<1>(va, pva), dpp_prev<1>(vb, pvb)}, v2 = {dpp_prev<2>(va, pva), dpp_prev<2>(vb, pvb)};
                    const f32x2 u = __builtin_elementwise_fma(wg2, g0, __builtin_elementwise_fma(wg1, g1, __builtin_elementwise_fma(wg0, g2, bg)));
                    const f32x2 x = __builtin_elementwise_fma(wv2, v0, __builtin_elementwise_fma(wv1, v1, __builtin_elementwise_fma(wv0, v2, bv)));
                    constexpr float K0 = -2.0f * LOG2E * 0.7978845608028654f, K1 = K0 * 0.044715f;
                    const f32x2 ez = u * (u * u * K1 + K0);
                    const f32x2 den = (f32x2){fast_exp2(ez[0]), fast_exp2(ez[1])} + 1.0f;
                    const f32x2 y = u * x * (f32x2){__builtin_amdgcn_rcpf(den[0]), __builtin_amdgcn_rcpf(den[1])};
                    outw[m][ep] = cvt_pk_bf16(y[0], y[1]);
                    pga = ga; pgb = gb; pva = va; pvb = vb;
                }
            }
#pragma unroll
            for (int m = 0; m < 4; ++m) { u32x4 w; w.x = outw[m][0]; w.y = outw[m][1]; w.z = outw[m][2]; w.w = outw[m][3];
                *(u32x4*)(ACT + (size_t)(u.pm * 256 + ai * 128 + wr * 64 + m * 16 + fr) * DFF + ch0) = w; }
            asm volatile("" ::: "memory");
        }
        if (wr == 1 && fr >= 14) { float* gp = UH + ((size_t)u.pm * 2 + (fr - 14)) * N_UP + u.pn * 256 + chl;
#pragma unroll
            for (int bj = 0; bj < 2; ++bj) { *(f32x4*)(gp + bj * 128) = acc[1][bj][3][0]; *(f32x4*)(gp + bj * 128 + 4) = acc[1][bj][3][1]; } }
        if (wr == 0 && fr < 2) { float* gp = UF + ((size_t)u.pm * 2 + fr) * N_UP + u.pn * 256 + chl;
#pragma unroll
            for (int bj = 0; bj < 2; ++bj) { *(f32x4*)(gp + bj * 128) = acc[0][bj][0][0]; *(f32x4*)(gp + bj * 128 + 4) = acc[0][bj][0][1]; } }
    }
};
__device__ __forceinline__ void fixup_item(const float* UH, const float* UF, const float* cw, const float* cb, bf16_t* ACT, int pm, int rr, int chunk) {
    {
        const int c0 = chunk * 8, colg = (c0 >> 7) * 256 + (c0 & 127);
        float o[8];
#pragma unroll
        for (int h = 0; h < 2; ++h) {
            const f32x4 gm2 = *(const f32x4*)(UH + ((size_t)(pm - 1) * 2 + 0) * N_UP + colg + 4 * h), gm1 = *(const f32x4*)(UH + ((size_t)(pm - 1) * 2 + 1) * N_UP + colg + 4 * h);
            const f32x4 g0 = *(const f32x4*)(UF + ((size_t)pm * 2 + 0) * N_UP + colg + 4 * h), g1 = *(const f32x4*)(UF + ((size_t)pm * 2 + 1) * N_UP + colg + 4 * h);
            const f32x4 vm2 = *(const f32x4*)(UH + ((size_t)(pm - 1) * 2 + 0) * N_UP + colg + 128 + 4 * h), vm1 = *(const f32x4*)(UH + ((size_t)(pm - 1) * 2 + 1) * N_UP + colg + 128 + 4 * h);
            const f32x4 v0 = *(const f32x4*)(UF + ((size_t)pm * 2 + 0) * N_UP + colg + 128 + 4 * h), v1 = *(const f32x4*)(UF + ((size_t)pm * 2 + 1) * N_UP + colg + 128 + 4 * h);
#pragma unroll
            for (int e = 0; e < 4; ++e) { const int c = c0 + 4 * h + e;
                const float a2 = rr ? gm1[e] : gm2[e], a1 = rr ? g0[e] : gm1[e], a0 = rr ? g1[e] : g0[e];
                const float b2 = rr ? vm1[e] : vm2[e], b1 = rr ? v0[e] : vm1[e], b0 = rr ? v1[e] : v0[e];
                const float ug = cw[c] * a2 + cw[N_UP + c] * a1 + cw[2 * N_UP + c] * a0 + cb[c];
                const float uv = cw[DFF + c] * b2 + cw[N_UP + DFF + c] * b1 + cw[2 * N_UP + DFF + c] * b0 + cb[DFF + c];
                o[4 * h + e] = gelu_tanh(ug) * uv; }
        }
        store_bf16x8(ACT + (size_t)(pm * 256 + rr) * DFF + c0, o);
    }
}
__device__ __forceinline__ void fixup_phase(const float* UH, const float* UF, const float* cw, const float* cb, bf16_t* ACT, int wv) {
    const int gt = (int)blockIdx.x * (NWAVES * 64) + opaque_tid(wv), NT = (int)gridDim.x * NWAVES * 64;
    constexpr int NCH = DFF / 8;
    for (int it = gt; it < 56 * 2 * NCH; it += NT) {
        const int chunk = it % NCH, rr = (it / NCH) & 1, k = it / (2 * NCH), pm = (k / 7) * 8 + (k % 7) + 1;
        fixup_item(UH, UF, cw, cb, ACT, pm, rr, chunk);
    }
}
__device__ __forceinline__ void fixup_local(const float* UH, const float* UF, const float* cw, const float* cb, bf16_t* ACT, int wv, int cid) {
    pg8::StaticOrder S; S.init(M, DM, (int)gridDim.x, cid);
    const int tid = opaque_tid(wv); constexpr int NCH = DFF / 8;
    pg8::Unit u; int prev = -1;
    for (int i = 0; S.next(i, u); ++i) {
        if (u.pm == prev || (u.pm & 7) == 0) continue;
        prev = u.pm;
#pragma unroll
        for (int j = 0; j < 3; ++j) { const int it = tid + j * (NWAVES * 64), itc = it < 2 * NCH ? it : 2 * NCH - 1; fixup_item(UH, UF, cw, cb, ACT, u.pm, itc / NCH, itc % NCH); }
    }
    asm volatile("s_waitcnt vmcnt(0)" ::: "memory");
    __syncthreads();
}

__device__ __forceinline__ void flogit_phase(LAS unsigned char* lds, const bf16_t* Hm, const bf16_t* WfT, const EpiInProj& E, int wv, int cid) {
    const int tid = opaque_tid(wv), wave = __builtin_amdgcn_readfirstlane(tid >> 6), lane = tid & 63, fr = lane & 15, fq = lane >> 4;
    const int rb = wave & 3, kh = wave >> 2;
    LAS float* xch = (LAS float*)(lds + HALO_OFF) + (rb * 16 + fr) * 8;
    for (int blk0 = (cid & 7) * (SEQ / 16) + (cid >> 3) * 4; blk0 < ((cid & 7) + 1) * (SEQ / 16); blk0 += ((int)gridDim.x >> 3) * 4) {
        const int blk = blk0 + rb;
        f32x4 a0 = {0.f, 0.f, 0.f, 0.f}, a1 = a0;
        const bf16_t* ap = Hm + (size_t)(blk * 16 + fr) * DM + fq * 8 + kh * (DM / 2);
        const bf16_t* bp0 = WfT + (size_t)perm32(fr) * DM + fq * 8 + kh * (DM / 2);
        const bf16_t* bp1 = WfT + (size_t)perm32(16 + fr) * DM + fq * 8 + kh * (DM / 2);
#pragma unroll 8
        for (int k0 = 0; k0 < DM / 2; k0 += 32) {
            const bf16x8 af = *(const bf16x8*)(ap + k0), b0 = *(const bf16x8*)(bp0 + k0), b1 = *(const bf16x8*)(bp1 + k0);
            a0 = __builtin_amdgcn_mfma_f32_16x16x32_bf16(b0, af, a0, 0, 0, 0); a1 = __builtin_amdgcn_mfma_f32_16x16x32_bf16(b1, af, a1, 0, 0, 0);
        }
        if (kh == 1 && fq == 0) { *(LAS f32x4*)xch = a0; *(LAS f32x4*)(xch + 4) = a1; }
        __syncthreads();
        if (kh == 0 && fq == 0) { const f32x4 c0 = *(const LAS f32x4*)xch, c1 = *(const LAS f32x4*)(xch + 4);
            const float v[8] = {a0[0] + c0[0], a0[1] + c0[1], a0[2] + c0[2], a0[3] + c0[3], a1[0] + c1[0], a1[1] + c1[1], a1[2] + c1[2], a1[3] + c1[3]}; E(blk * 16 + fr, N_QKV, v, 30); }
        __syncthreads();
    }
}
template <bool F8 = false, class Epi>
__device__ __forceinline__ void run_gemm(LAS unsigned char* lds, const Gemm g, const Epi& E, int wv, int cid, int split = 0) {
#if FAST_GEMM
    pg8::StaticOrder S; S.init(g.M, g.N, (int)gridDim.x, cid); S.split = (split && S.nwg == 4 * (int)gridDim.x) ? 1 : 0;
    pg8::gemm_phase<Epi, GEMM_ALIGN, GEMM_SP2, F8>(lds, g, S, E, wv);
#else
    static_assert(!Epi::TILE && !Epi::MID && !F8, "tile / mid-loop epilogues and fp8 operands need the fast body");
    const int tid = opaque_tid(wv), wave = __builtin_amdgcn_readfirstlane(tid >> 6);
    gemm_naive(g, E, (int)blockIdx.x * NWAVES + wave, (int)gridDim.x * NWAVES, tid & 63);
#endif
}

__device__ __forceinline__ unsigned pk4_fp8(float a, float b, float c, float d) {
    a = fminf(fmaxf(a, -440.f), 440.f); b = fminf(fmaxf(b, -440.f), 440.f); c = fminf(fmaxf(c, -440.f), 440.f); d = fminf(fmaxf(d, -440.f), 440.f);
    int w = 0; w = __builtin_amdgcn_cvt_pk_fp8_f32(a, b, w, false); w = __builtin_amdgcn_cvt_pk_fp8_f32(c, d, w, true); return (unsigned)w;
}
__device__ __forceinline__ void transpose_item_f8(const float* W, int ldw, int c0, int K, int ncols, unsigned char* WT8, float scale, LAS float* scr, int item, int lane) {
    const int nblk = ncols / 32, kb = item / nblk, nb = item % nblk, k0 = 64 * kb, n0 = 32 * nb;
    const int gc = n0 < DM ? n0 : n0 - DM, ro = 256 * (gc >> 7) + (n0 < DM ? 0 : 128) + (gc & 127) - n0;
#pragma unroll
    for (int i = 0; i < 8; ++i) { const int kk = 8 * i + (lane >> 3);
        const f32x4 v = *(const f32x4*)(W + (size_t)(k0 + kk) * ldw + c0 + n0 + (lane & 7) * 4); LAS float* d = scr + kk * 33 + (lane & 7) * 4;
        d[0] = v[0] * scale; d[1] = v[1] * scale; d[2] = v[2] * scale; d[3] = v[3] * scale; }
    asm volatile("s_waitcnt lgkmcnt(0)" ::: "memory");
    const int c = lane & 7;
#pragma unroll
    for (int j = 0; j < 4; ++j) { const int n = (lane >> 3) + 8 * j; const LAS float* s = scr + (8 * c) * 33 + n;
        u32x2 o; o.x = pk4_fp8(s[0 * 33], s[1 * 33], s[2 * 33], s[3 * 33]); o.y = pk4_fp8(s[4 * 33], s[5 * 33], s[6 * 33], s[7 * 33]);
        *(u32x2*)(WT8 + (size_t)(ro + n0 + n) * K + k0 + 8 * c) = o; }
    asm volatile("s_waitcnt lgkmcnt(0)" ::: "memory");
}
template <bool UPPERM = false>
__device__ __forceinline__ void transpose_item(const float* W, int ldw, int c0, int K, int ncols, bf16_t* WT, int row_off, LAS float* scr, int item, int lane, int ldk = 0, int koff = 0) {
    if (ldk == 0) ldk = K;
    const int nblk = ncols / 32, kb = item / nblk, nb = item % nblk, k0 = 64 * kb, n0 = 32 * nb;
    if (UPPERM) { const int c = n0 < DFF ? n0 : n0 - DFF; row_off = 256 * (c >> 7) + (n0 < DFF ? 0 : 128) + (c & 127) - n0; }
#pragma unroll
    for (int i = 0; i < 8; ++i) { const int kk = 8 * i + (lane >> 3);
        const f32x4 v = *(const f32x4*)(W + (size_t)(k0 + kk) * ldw + c0 + n0 + (lane & 7) * 4); LAS float* d = scr + kk * 33 + (lane & 7) * 4;
        d[0] = v[0]; d[1] = v[1]; d[2] = v[2]; d[3] = v[3]; }
    asm volatile("s_waitcnt lgkmcnt(0)" ::: "memory");
    const int c = lane & 7;
#pragma unroll
    for (int j = 0; j < 4; ++j) { const int n = (lane >> 3) + 8 * j; const LAS float* s = scr + (8 * c) * 33 + n;
        u32x4 o; o.x = cvt_pk_bf16(s[0 * 33], s[1 * 33]); o.y = cvt_pk_bf16(s[2 * 33], s[3 * 33]); o.z = cvt_pk_bf16(s[4 * 33], s[5 * 33]); o.w = cvt_pk_bf16(s[6 * 33], s[7 * 33]);
        *(u32x4*)(WT + (size_t)(row_off + n0 + n) * ldk + koff + k0 + 8 * c) = o; }
    asm volatile("s_waitcnt lgkmcnt(0)" ::: "memory");
}
__device__ __forceinline__ void rms_row_to_bf16(const float* xrow, const f32x4 (&gv)[8], bf16_t* orow, bf16_t* xcopy, int lane, unsigned char* o8) {
    f32x4 v[8]; float s = 0.f;
#pragma unroll
    for (int j = 0; j < 8; ++j) { v[j] = *((const f32x4*)xrow + 2 * (lane + 64 * (j >> 1)) + (j & 1)); s += (v[j][0] * v[j][0] + v[j][1] * v[j][1]) + (v[j][2] * v[j][2] + v[j][3] * v[j][3]); }
    const float r = 1.0f / sqrtf(wave_sum(s) * (1.0f / DM) + EPS);
#pragma unroll
    for (int c = 0; c < 4; ++c) {
        if (xcopy) { u32x4 w; w.x = cvt_pk_bf16(v[2 * c][0], v[2 * c][1]); w.y = cvt_pk_bf16(v[2 * c][2], v[2 * c][3]); w.z = cvt_pk_bf16(v[2 * c + 1][0], v[2 * c + 1][1]); w.w = cvt_pk_bf16(v[2 * c + 1][2], v[2 * c + 1][3]);
            *((u32x4*)xcopy + lane + 64 * c) = w; }
        const f32x4 a = v[2 * c] * r * gv[2 * c], b = v[2 * c + 1] * r * gv[2 * c + 1];
        u32x4 w; w.x = cvt_pk_bf16(a[0], a[1]); w.y = cvt_pk_bf16(a[2], a[3]); w.z = cvt_pk_bf16(b[0], b[1]); w.w = cvt_pk_bf16(b[2], b[3]);
        *((u32x4*)orow + lane + 64 * c) = w;
        u32x2 q; q.x = pk4_fp8(a[0] * H8_SCALE, a[1] * H8_SCALE, a[2] * H8_SCALE, a[3] * H8_SCALE); q.y = pk4_fp8(b[0] * H8_SCALE, b[1] * H8_SCALE, b[2] * H8_SCALE, b[3] * H8_SCALE);
        *((u32x2*)o8 + lane + 64 * c) = q;
    }
}

struct Ptrs {
    const float *x, *rel_bias, *w_in, *b_f, *w_pa, *w_pb, *w_o, *w_up, *conv_w, *conv_b, *w_down, *g_mix_pre, *g_mix_post, *g_ffn_pre, *g_ffn_post;
    float* out; unsigned char* ws;
};

struct TrItem { const float* src; unsigned char* dst; int ldw, ldkb; float scale; int f8; };
__device__ __forceinline__ TrItem tr_make(const float* W, int ldw, int c0, int K, int ncols, void* WT, int row_off, int item, int ldk, int koff, bool upperm, bool f8, float scale) {
    if (ldk == 0) ldk = K;
    const int nblk = ncols / 32, kb = item / nblk, nb = item % nblk, k0 = 64 * kb, n0 = 32 * nb;
    if (upperm) { const int c = n0 < DFF ? n0 : n0 - DFF; row_off = 256 * (c >> 7) + (n0 < DFF ? 0 : 128) + (c & 127) - n0; }
    if (f8) { const int c = n0 < DM ? n0 : n0 - DM; row_off = 256 * (c >> 7) + (n0 < DM ? 0 : 128) + (c & 127) - n0; }
    TrItem t; t.src = W + (size_t)k0 * ldw + c0 + n0; t.ldw = ldw; t.scale = scale; t.f8 = f8 ? 1 : 0; const int esz = f8 ? 1 : 2;
    t.dst = (unsigned char*)WT + ((size_t)(row_off + n0) * ldk + koff + k0) * esz; t.ldkb = ldk * esz; return t;
}
__device__ __forceinline__ void tr_load(const TrItem& t, f32x4 (&v)[8], int lane) {
#pragma unroll
    for (int i = 0; i < 8; ++i) v[i] = *(const f32x4*)(t.src + (size_t)(8 * i + (lane >> 3)) * t.ldw + (lane & 7) * 4);
}
__device__ __forceinline__ void tr_finish(const TrItem& t, const f32x4 (&v)[8], LAS float* scr, int lane) {
#pragma unroll
    for (int i = 0; i < 8; ++i) { LAS float* d = scr + (8 * i + (lane >> 3)) * 33 + (lane & 7) * 4; d[0] = v[i][0] * t.scale; d[1] = v[i][1] * t.scale; d[2] = v[i][2] * t.scale; d[3] = v[i][3] * t.scale; }
    asm volatile("s_waitcnt lgkmcnt(0)" ::: "memory");
    const int c = lane & 7;
#pragma unroll
    for (int j = 0; j < 4; ++j) { const int n = (lane >> 3) + 8 * j; const LAS float* sp = scr + (8 * c) * 33 + n;
        const float e0 = sp[0 * 33], e1 = sp[1 * 33], e2 = sp[2 * 33], e3 = sp[3 * 33], e4 = sp[4 * 33], e5 = sp[5 * 33], e6 = sp[6 * 33], e7 = sp[7 * 33];
        if (t.f8) { u32x2 o; o.x = pk4_fp8(e0, e1, e2, e3); o.y = pk4_fp8(e4, e5, e6, e7); *(u32x2*)(t.dst + (size_t)n * t.ldkb + 8 * c) = o; }
        else { u32x4 o; o.x = cvt_pk_bf16(e0, e1); o.y = cvt_pk_bf16(e2, e3); o.z = cvt_pk_bf16(e4, e5); o.w = cvt_pk_bf16(e6, e7); *(u32x4*)(t.dst + (size_t)n * t.ldkb + 16 * c) = o; } }
    asm volatile("s_waitcnt lgkmcnt(0)" ::: "memory");
}
namespace cv {
constexpr int I_IN1 = (DM / 64) * (N_QKV / 32), I_IN2 = (DM / 64) * (N_G / 32), I_PA = (512 / 64) * (DM / 32), I_PB = (1024 / 64) * (DM / 32), I_O = (DM / 64) * (DM / 32),
              I_UP = (DM / 64) * (N_UP / 32), I_DN = (DFF / 64) * (DM / 32);
constexpr int PER_LAYER = I_IN1 + I_IN2 + I_PA + I_PB + I_O + I_UP + I_DN;
static_assert(PER_LAYER % 8 == 0, "a layer's transpose items split evenly over the eight groups");
}
__device__ __forceinline__ void convert_range(const Ptrs& P, LAS float* scr, int layer, int r_begin, int r_end, int first, int stride, int lane) {
    using namespace cv;
    unsigned char* ws = P.ws;
    bf16_t* win = (bf16_t*)(ws + WS_WIN + layer * SZ_WIN);
    const float* w_in = P.w_in + (size_t)layer * DM * N_IN;
    for (int it = r_begin + first; it < r_end; it += stride) {
        int r = it;
        if (r < I_IN1) { transpose_item(w_in, N_IN, 0, DM, N_QKV, win, 0, scr, r, lane); continue; } r -= I_IN1;
        if (r < I_IN2) { transpose_item_f8(w_in, N_IN, N_QKV + 8, DM, N_G, (unsigned char*)win + OFF_WG8, W8_SCALE, scr, r, lane); continue; } r -= I_IN2;
        if (r < I_PA) { transpose_item(P.w_pa + (size_t)layer * 512 * DM, DM, 0, 512, DM, (bf16_t*)(ws + WS_WPA + layer * SZ_WPAB), 0, scr, r, lane, YAB_W, 0); continue; } r -= I_PA;
        if (r < I_PB) { transpose_item(P.w_pb + (size_t)layer * 1024 * DM, DM, 0, 1024, DM, (bf16_t*)(ws + WS_WPA + layer * SZ_WPAB), 0, scr, r, lane, YAB_W, 512); continue; } r -= I_PB;
        if (r < I_O) { transpose_item(P.w_o + (size_t)layer * DM * DM, DM, 0, DM, DM, (bf16_t*)(ws + WS_WO + layer * SZ_WO), 0, scr, r, lane); continue; } r -= I_O;
        if (r < I_UP) { transpose_item<true>(P.w_up + (size_t)layer * DM * N_UP, N_UP, 0, DM, N_UP, (bf16_t*)(ws + WS_WUP + layer * SZ_WUP), 0, scr, r, lane); continue; } r -= I_UP;
        transpose_item(P.w_down + (size_t)layer * DFF * DM, DM, 0, DFF, DM, (bf16_t*)(ws + WS_WDN + layer * SZ_WDN), 0, scr, r, lane);
    }
}
__device__ __forceinline__ void convert_range_pipe(const Ptrs& P, LAS float* scr, int layer, int r_begin, int r_end, int first, int stride, int lane) {
    using namespace cv;
    unsigned char* ws = P.ws;
    auto decode = [&](int it) -> TrItem {
        int r = it;
        bf16_t* win = (bf16_t*)(ws + WS_WIN + layer * SZ_WIN);
        const float* w_in = P.w_in + (size_t)layer * DM * N_IN;
        if (r < I_IN1) return tr_make(w_in, N_IN, 0, DM, N_QKV, win, 0, r, 0, 0, false, false, 1.0f); r -= I_IN1;
        if (r < I_IN2) return tr_make(w_in, N_IN, N_QKV + 8, DM, N_G, (unsigned char*)win + OFF_WG8, 0, r, 0, 0, false, true, W8_SCALE); r -= I_IN2;
        if (r < I_PA) return tr_make(P.w_pa + (size_t)layer * 512 * DM, DM, 0, 512, DM, ws + WS_WPA + layer * SZ_WPAB, 0, r, YAB_W, 0, false, false, 1.0f); r -= I_PA;
        if (r < I_PB) return tr_make(P.w_pb + (size_t)layer * 1024 * DM, DM, 0, 1024, DM, ws + WS_WPA + layer * SZ_WPAB, 0, r, YAB_W, 512, false, false, 1.0f); r -= I_PB;
        if (r < I_O) return tr_make(P.w_o + (size_t)layer * DM * DM, DM, 0, DM, DM, ws + WS_WO + layer * SZ_WO, 0, r, 0, 0, false, false, 1.0f); r -= I_O;
        if (r < I_UP) return tr_make(P.w_up + (size_t)layer * DM * N_UP, N_UP, 0, DM, N_UP, ws + WS_WUP + layer * SZ_WUP, 0, r, 0, 0, true, false, 1.0f); r -= I_UP;
        return tr_make(P.w_down + (size_t)layer * DFF * DM, DM, 0, DFF, DM, ws + WS_WDN + layer * SZ_WDN, 0, r, 0, 0, false, false, 1.0f);
    };
    f32x4 va[8], vb[8]; TrItem ta, tb;
    int it = r_begin + first;
    if (it < r_end) { ta = decode(it); tr_load(ta, va, lane); }
    for (; it < r_end; it += 2 * stride) {
        const bool hb = it + stride < r_end;
        if (hb) { tb = decode(it + stride); tr_load(tb, vb, lane); }
        tr_finish(ta, va, scr, lane);
        if (!hb) break;
        if (it + 2 * stride < r_end) { ta = decode(it + 2 * stride); tr_load(ta, va, lane); }
        tr_finish(tb, vb, scr, lane);
    }
}
__device__ __forceinline__ void convert_share(const Ptrs& P, LAS unsigned char* lds, int layer, int wv, int cid, int lo = 0, int hi = cv::PER_LAYER, int rank0 = 0) {
    const int tid = opaque_tid(wv), wave = __builtin_amdgcn_readfirstlane(tid >> 6), lane = tid & 63;
    LAS float* scr = (LAS float*)(lds + wave * 16384);
    const int g = cid & 7, per = (hi - lo) / 8, rk = (cid >> 3) - rank0;
    if (rk < 0 || rk >= CV_WGS) return;
    convert_range_pipe(P, scr, layer, lo + g * per, lo + (g + 1) * per, rk * NWAVES + wave, CV_WGS * NWAVES, lane);
    asm volatile("s_waitcnt vmcnt(0)" ::: "memory"); __syncthreads();
}
__device__ __forceinline__ void p0_prologue(const Ptrs& P, LAS unsigned char* lds, int wv) {
    const int tid = opaque_tid(wv), wave = __builtin_amdgcn_readfirstlane(tid >> 6), lane = tid & 63;
    LAS float* scr = (LAS float*)(lds + wave * 16384);
    const int gw = (int)blockIdx.x * NWAVES + wave, NGW = (int)gridDim.x * NWAVES;
    unsigned char* ws = P.ws;
    for (int layer = 0; layer < (LATE_CONVERT ? 1 : DEPTH); ++layer) convert_range(P, scr, layer, 0, (LATE_CONVERT && LATE0) ? cv::I_IN1 + cv::I_IN2 : cv::PER_LAYER, gw, NGW, lane);
    {
        const int gt = (int)blockIdx.x * (NWAVES * 64) + tid, NT = (int)gridDim.x * NWAVES * 64;
        for (int i = gt; i < DEPTH * 256 * DM; i += NT) {
            const int layer = i / (256 * DM), rr = (i / DM) % 256, k = i % DM;
            const float v = rr < 8 ? P.w_in[(size_t)layer * DM * N_IN + (size_t)k * N_IN + N_QKV + rr] : 0.f;
            ((bf16_t*)(ws + WS_WIN + layer * SZ_WIN))[(size_t)(N_QKV + rr) * DM + k] = (bf16_t)(cvt_pk_bf16(v, 0.f) & 0xffffu);
        }
        float* tab = (float*)(ws + WS_TAB);
        for (int i = gt; i < 12 * 132; i += NT) {
            const int head = i / 132, d = i % 132, g = head >> 2, dil = g == 0 ? 1 : (g == 1 ? 4 : 16);
            tab[i] = P.rel_bias[t5_bucket(d * dil) * 12 + head] * LOG2E;
        }
    }
    {
        f32x4 gv[8];
#pragma unroll
        for (int j = 0; j < 8; ++j) gv[j] = *((const f32x4*)P.g_mix_pre + 2 * (lane + 64 * (j >> 1)) + (j & 1));
        bf16_t* H = (bf16_t*)(ws + WS_H); bf16_t* XBr = (bf16_t*)(ws + WS_XB);
        for (int m = gw; m < M; m += NGW) rms_row_to_bf16(P.x + (size_t)m * DM, gv, H + (size_t)m * DM, (bf16_t*)(ws + WS_XB) + (size_t)m * DM, lane, ws + WS_H8 + (size_t)m * DM);
    }
}

__device__ __forceinline__ void attn_naive(const bf16_t* QKV, const float* LOGF, const float* TAB, bf16_t* YAB, int wv) {
    const int tid = opaque_tid(wv), lane = tid & 63, gw = (int)blockIdx.x * NWAVES + __builtin_amdgcn_readfirstlane(tid >> 6), ngw = (int)gridDim.x * NWAVES;
    for (int i = gw, k = 0; i < BATCH * 8 * SEQ; i += ngw, ++k) {
        const int bh = i >> 11; int t = i & 2047; if (k & 1) t = 2047 - t;
        const int b = bh >> 3, h = bh & 7;
        const unsigned qw = *(const unsigned*)(QKV + (size_t)(b * SEQ + t) * N_QKV + N_A + h * HD + 2 * lane);
        const float q0 = bf_lo(qw), q1 = bf_hi(qw);
        float m = -1e30f, l = 0.f, o0 = 0.f, o1 = 0.f, c = 0.f;
        for (int s = 0; s <= t; ++s) {
            const bf16_t* kp = QKV + (size_t)(b * SEQ + s) * N_QKV + N_A + 1024 + h * HD + 2 * lane;
            const unsigned kw = *(const unsigned*)kp, vw = *(const unsigned*)(kp + 1024);
            c += LOGF[(size_t)(b * SEQ + s) * 8 + h];
            const float sc = wave_sum(q0 * bf_lo(kw) + q1 * bf_hi(kw)) - c * LOG2E;
            const float mn = fmaxf(m, sc), al = fast_exp2(m - mn), p = fast_exp2(sc - mn);
            l = l * al + p; o0 = o0 * al + p * bf_lo(vw); o1 = o1 * al + p * bf_hi(vw); m = mn;
        }
        const float il = 1.0f / l;
        *(unsigned*)(YAB + (size_t)(b * SEQ + t) * YAB_W + 512 + h * HD + 2 * lane) = cvt_pk_bf16(o0 * il, o1 * il);
    }
    for (int i = gw; i < M * 4; i += ngw) {
        const int row = i >> 2, hs = i & 3, t = row & 2047;
        float m = -1e30f, l = 0.f, o0 = 0.f, o1 = 0.f;
        for (int g = 0; g < 3; ++g) {
            const int dil = g == 0 ? 1 : (g == 1 ? 4 : 16), head = g * 4 + hs;
            const unsigned qw = *(const unsigned*)(QKV + (size_t)row * N_QKV + head * HD + 2 * lane);
            const float q0 = bf_lo(qw), q1 = bf_hi(qw);
            for (int j = 0; j <= 128; ++j) {
                const int s = t - j * dil; if (s < 0) break;
                const bf16_t* kp = QKV + (size_t)(row - j * dil) * N_QKV + 1536 + head * HD + 2 * lane;
                const unsigned kw = *(const unsigned*)kp, vw = *(const unsigned*)(kp + 1536);
                const float sc = wave_sum(q0 * bf_lo(kw) + q1 * bf_hi(kw)) + TAB[head * 132 + j];
                const float mn = fmaxf(m, sc), al = fast_exp2(m - mn), p = fast_exp2(sc - mn);
                l = l * al + p; o0 = o0 * al + p * bf_lo(vw); o1 = o1 * al + p * bf_hi(vw); m = mn;
            }
        }
        const float il = 1.0f / l;
        *(unsigned*)(YAB + (size_t)row * YAB_W + hs * HD + 2 * lane) = cvt_pk_bf16(o0 * il, o1 * il);
    }
}


namespace att {
typedef short s16x4 __attribute__((ext_vector_type(4)));
typedef float f32x16 __attribute__((ext_vector_type(16)));
constexpr int KVBLK = 64, SHM_V = 16384, SHM_K = 16384;
constexpr int SUPER = 65536, OFF_K = 0, OFF_V = 32768, OFF_BIAS = HALO_OFF, OFF_WS = HALO_OFF + 8192;
static_assert(2 * SUPER <= LDSCTL_OFF && OFF_WS + NWAVES * 64 * 4 <= LDS_BYTES && (HALO_OFF % 16) == 0, "attention LDS map");
constexpr float THR = 8.f;
constexpr int NUNITS = 192;
#define KSWZ(row, colB) ((row) * 256 + ((colB) ^ (((row) & 7) << 4)))
#define SBAR() __builtin_amdgcn_sched_barrier(0)
__device__ __forceinline__ int v_st(int k, int c) { const int kk = (k & ~0xC) | ((k & 4) << 1) | ((k & 8) >> 1); return ((kk >> 3) * 4 + (c >> 5)) * 512 + ((kk & 7) * 32 + (c & 31)) * 2; }
__device__ __forceinline__ int v_rd_base(int lane) { return ((lane & 3) << 3) | (((lane >> 2) & 3) << 6) | (((lane >> 4) & 1) << 5) | (((lane >> 5) & 1) << 8); }
constexpr int v_rd_off(int d0, int ks, int half) { return d0 * 512 + ks * 4096 + half * 2048; }
__device__ __forceinline__ int crow(int r, int hi) { return (r & 3) + 8 * (r >> 2) + 4 * hi; }

__device__ __forceinline__ void softmax_tile(f32x16& p0, f32x16& p1, float& m_reg, float& l_reg, float& alpha, bf16x8& pa0, bf16x8& pa1, bf16x8& pa2, bf16x8& pa3) {
    float pmax = p0[0];
#pragma unroll
    for (int r = 1; r < 16; ++r) pmax = fmaxf(pmax, p0[r]);
#pragma unroll
    for (int r = 0; r < 16; ++r) pmax = fmaxf(pmax, p1[r]);
    { auto rr = __builtin_amdgcn_permlane32_swap(__float_as_uint(pmax), __float_as_uint(pmax), false, false);
      pmax = fmaxf(__uint_as_float(rr[0]), __uint_as_float(rr[1])); }
    float mn;
    if (__builtin_expect(__all((pmax - m_reg) <= THR), 1)) { mn = m_reg; alpha = 1.f; }
    else { mn = fmaxf(m_reg, pmax); alpha = __builtin_amdgcn_exp2f(m_reg - mn); m_reg = mn; }
#pragma unroll
    for (int r = 0; r < 16; ++r) p0[r] = __builtin_amdgcn_exp2f(p0[r] - mn);
#pragma unroll
    for (int r = 0; r < 16; ++r) p1[r] = __builtin_amdgcn_exp2f(p1[r] - mn);
    float ps = 0;
#pragma unroll
    for (int r = 0; r < 16; ++r) ps += p0[r];
#pragma unroll
    for (int r = 0; r < 16; ++r) ps += p1[r];
    { auto rr = __builtin_amdgcn_permlane32_swap(__float_as_uint(ps), __float_as_uint(ps), false, false);
      ps = __uint_as_float(rr[0]) + __uint_as_float(rr[1]); }
    l_reg = l_reg * alpha + ps;
#define PK4(P, B_, OUT) do { unsigned a0 = cvt_pk_bf16(P[B_+0], P[B_+1]), a1 = cvt_pk_bf16(P[B_+2], P[B_+3]);                          \
        unsigned b0 = cvt_pk_bf16(P[B_+4], P[B_+5]), b1 = cvt_pk_bf16(P[B_+6], P[B_+7]);                                             \
        auto r0 = __builtin_amdgcn_permlane32_swap(a0, b0, false, false); auto r1 = __builtin_amdgcn_permlane32_swap(a1, b1, false, false); \
        u32x4 w = {r0[0], r1[0], r0[1], r1[1]}; OUT = *reinterpret_cast<bf16x8*>(&w); } while (0)
    PK4(p0, 0, pa0); PK4(p0, 8, pa1); PK4(p1, 0, pa2); PK4(p1, 8, pa3);
#undef PK4
}
__device__ __forceinline__ void qkt(f32x16& p0, f32x16& p1, LAS unsigned char* kbase, int r32, int hi, const bf16x8 (&qr)[8]) {
    int ka[4];
#pragma unroll
    for (int dd = 0; dd < 4; ++dd) ka[dd] = (int)(uintptr_t)(kbase + KSWZ(r32, (dd * 16 + hi * 8) * 2));
    bf16x8 f0a, f0b, f1a, f1b;
#define KRD(A, B, d0) asm volatile("ds_read_b128 %0, %2 offset:%3\n\tds_read_b128 %1, %2 offset:%4" : "=&v"(A), "=&v"(B) : "v"(ka[(d0) & 3]), "i"(((d0) >> 2) * 128), "i"(((d0) >> 2) * 128 + 32 * 256) : "memory")
#define KMM(A, B, d0) do { p0 = __builtin_amdgcn_mfma_f32_32x32x16_bf16(A, qr[d0], p0, 0, 0, 0); p1 = __builtin_amdgcn_mfma_f32_32x32x16_bf16(B, qr[d0], p1, 0, 0, 0); } while (0)
#define KW(n) do { asm volatile("s_waitcnt lgkmcnt(" #n ")" ::: "memory"); SBAR(); } while (0)
    KRD(f0a, f0b, 0);
    __builtin_amdgcn_s_setprio(1);
    KRD(f1a, f1b, 1); KW(2); KMM(f0a, f0b, 0); SBAR();
    KRD(f0a, f0b, 2); KW(2); KMM(f1a, f1b, 1); SBAR();
    KRD(f1a, f1b, 3); KW(2); KMM(f0a, f0b, 2); SBAR();
    KRD(f0a, f0b, 4); KW(2); KMM(f1a, f1b, 3); SBAR();
    KRD(f1a, f1b, 5); KW(2); KMM(f0a, f0b, 4); SBAR();
    KRD(f0a, f0b, 6); KW(2); KMM(f1a, f1b, 5); SBAR();
    KRD(f1a, f1b, 7); KW(2); KMM(f0a, f0b, 6); SBAR();
    KW(0); KMM(f1a, f1b, 7);
    __builtin_amdgcn_s_setprio(0);
#undef KRD
#undef KMM
#undef KW
}
__device__ __forceinline__ void pv_tile(f32x16 (&o)[4], int vb0, bf16x8 pa0, bf16x8 pa1, bf16x8 pa2, bf16x8 pa3) {
#define TRRD(dst, off) asm volatile("ds_read_b64_tr_b16 %0, %1 offset:%2" : "=&v"(dst) : "v"(vb0), "i"(off) : "memory")
#define TRSET(S, d0) do { constexpr int b_ = v_rd_off(d0, 0, 0);   \
        TRRD(S##l0, b_); TRRD(S##h0, b_ + 2048); TRRD(S##l1, b_ + 4096); TRRD(S##h1, b_ + 6144); TRRD(S##l2, b_ + 8192); TRRD(S##h2, b_ + 10240); TRRD(S##l3, b_ + 12288); TRRD(S##h3, b_ + 14336); } while (0)
#define PVMM(S, d0) do {   \
        o[d0] = __builtin_amdgcn_mfma_f32_32x32x16_bf16(pa0, (bf16x8){S##l0[0], S##l0[1], S##l0[2], S##l0[3], S##h0[0], S##h0[1], S##h0[2], S##h0[3]}, o[d0], 0, 0, 0);   \
        o[d0] = __builtin_amdgcn_mfma_f32_32x32x16_bf16(pa1, (bf16x8){S##l1[0], S##l1[1], S##l1[2], S##l1[3], S##h1[0], S##h1[1], S##h1[2], S##h1[3]}, o[d0], 0, 0, 0);   \
        o[d0] = __builtin_amdgcn_mfma_f32_32x32x16_bf16(pa2, (bf16x8){S##l2[0], S##l2[1], S##l2[2], S##l2[3], S##h2[0], S##h2[1], S##h2[2], S##h2[3]}, o[d0], 0, 0, 0);   \
        o[d0] = __builtin_amdgcn_mfma_f32_32x32x16_bf16(pa3, (bf16x8){S##l3[0], S##l3[1], S##l3[2], S##l3[3], S##h3[0], S##h3[1], S##h3[2], S##h3[3]}, o[d0], 0, 0, 0); } while (0)
#define PVW(n) do { asm volatile("s_waitcnt lgkmcnt(" #n ")" ::: "memory"); SBAR(); } while (0)
    s16x4 al0, al1, al2, al3, ah0, ah1, ah2, ah3, bl0, bl1, bl2, bl3, bh0, bh1, bh2, bh3;
    TRSET(a, 0);
    __builtin_amdgcn_s_setprio(1);
    TRSET(b, 1); PVW(8); PVMM(a, 0); SBAR();
    TRSET(a, 2); PVW(8); PVMM(b, 1); SBAR();
    TRSET(b, 3); PVW(8); PVMM(a, 2); SBAR();
    PVW(0); PVMM(b, 3);
    __builtin_amdgcn_s_setprio(0);
#undef TRSET
#undef PVMM
#undef PVW
#undef TRRD
}

__device__ __forceinline__ void attn_phase(LAS unsigned char* lds, const bf16_t* QKV, const float* LOGF, const float* TAB, bf16_t* YAB, bf16_t* OG, float* ML, unsigned* qctr0, int wv, int cid) {
    unsigned* qctr = qctr0 + 16 * (cid & 7); const int bq = cid & 7;
    const int tid = opaque_tid(wv), wid = __builtin_amdgcn_readfirstlane(tid >> 6), lane = tid & 63, r32 = lane & 31, hi = lane >> 5;
    volatile LAS unsigned* misc = (volatile LAS unsigned*)(lds + MISC_OFF);
    LAS float* wsf = (LAS float*)(lds + OFF_WS) + wid * 64;
    LAS float* biasf = (LAS float*)(lds + OFF_BIAS);
    const float NEG = -__builtin_inff();
    if (tid == 0) misc[0] = __hip_atomic_fetch_add(qctr, 1u, __ATOMIC_RELAXED, __HIP_MEMORY_SCOPE_AGENT);
    int upar = 0;
    for (;;) {
        __syncthreads();
        const int u = __builtin_amdgcn_readfirstlane((int)misc[upar]); upar ^= 1;
        if (u >= NUNITS) break;
        unsigned unext = 0;
        int mode, q0, nwa, kt_lo, kt_hi; size_t pitch, opitch, mlpitch = 0; const bf16_t *Qp, *Kp, *Vp; bf16_t* Op; float* MLp = nullptr; const float* lfp = nullptr; const float* tabp = nullptr;
        if (u < 64) {
            const int qb = 7 - (u >> 3), b = bq, h = u & 7;
            mode = 0; q0 = 256 * qb; nwa = 8; kt_lo = 0; kt_hi = 4 * (qb + 1); pitch = N_QKV; opitch = YAB_W;
            Kp = QKV + (size_t)(b * SEQ) * N_QKV + N_A + 1024 + h * HD; Vp = Kp + 1024; Qp = QKV + (size_t)(b * SEQ + q0) * N_QKV + N_A + h * HD;
            Op = YAB + (size_t)(b * SEQ + q0) * YAB_W + 512 + h * HD;
            lfp = LOGF + (size_t)(b * SEQ + 4 * tid) * 8 + h;
        } else {
            int g, b, hh, r, qb, dil;
            b = bq;
            if (u < 96) { const int v = u - 64; g = 0; dil = 1; qb = v >> 2; hh = v & 3; r = 0; nwa = 8; kt_lo = 4 * qb - 2; kt_hi = 4 * qb + 4; }
            else if (u < 128) { const int v = u - 96; g = 1; dil = 4; qb = v >> 4; hh = (v >> 2) & 3; r = v & 3; nwa = 8; kt_lo = 4 * qb - 2; kt_hi = 4 * qb + 4; }
            else { const int v = u - 128; g = 2; dil = 16; qb = 0; hh = v >> 4; r = v & 15; nwa = 4; kt_lo = 0; kt_hi = 2; }
            if (kt_lo < 0) kt_lo = 0;
            mode = 1; q0 = 256 * qb; const int head = g * 4 + hh; const size_t tok0 = (size_t)b * SEQ + r;
            pitch = (size_t)N_QKV * dil; opitch = (size_t)512 * dil; mlpitch = (size_t)8 * dil;
            Kp = QKV + tok0 * N_QKV + 1536 + head * HD; Vp = Kp + 1536; Qp = QKV + (tok0 + (size_t)q0 * dil) * N_QKV + head * HD;
            Op = OG + ((size_t)g * M + tok0 + (size_t)q0 * dil) * 512 + hh * HD;
            MLp = ML + (((size_t)g * M + tok0 + (size_t)q0 * dil) * 4 + hh) * 2;
            tabp = TAB + head * 132;
        }
        const bool wact = wid < nwa;
        const int qw = q0 + wid * 32;
        bf16x8 qr[8];
        if (wact) {
#pragma unroll
            for (int d0 = 0; d0 < 8; ++d0) qr[d0] = *(const bf16x8*)(Qp + (size_t)(wid * 32 + r32) * pitch + d0 * 16 + hi * 8);
        } else {
#pragma unroll
            for (int d0 = 0; d0 < 8; ++d0) qr[d0] = (bf16x8){0, 0, 0, 0, 0, 0, 0, 0};
        }
        float m_reg = -1e30f, l_reg = 0.f; f32x16 o[4];
#pragma unroll
        for (int d = 0; d < 4; ++d)
#pragma unroll
            for (int r = 0; r < 16; ++r) o[d][r] = 0.f;
        unsigned kof[4], vof[4];
        { int ln = lane; asm volatile("" : "+v"(ln));
#pragma unroll
          for (int i = 0; i < 4; ++i) {
              const int b = wid * 4 + i, j = b >> 4, blk = b & 15;
              const int row = blk * 4 + (ln >> 4), kkey = j * 64 + row, kcol = ((ln & 15) ^ (row & 7)) * 8;
              const int sub = blk * 2 + (ln >> 5), kk = (sub >> 2) * 8 + ((ln & 31) >> 2), k = (kk & ~0xC) | ((kk & 4) << 1) | ((kk & 8) >> 1);
              const int vkey = j * 64 + k, vcol = (sub & 3) * 32 + (ln & 3) * 8;
              kof[i] = (unsigned)(((size_t)kkey * pitch + kcol) * 2); vof[i] = (unsigned)(((size_t)vkey * pitch + vcol) * 2); } }
        const int s_lo = kt_lo >> 1, s_hi = kt_hi >> 1;
#define KVDMA(s_, bf_) do { const char* kg_ = (const char*)(Kp + (size_t)((s_) * 128) * pitch); const char* vg_ = (const char*)(Vp + (size_t)((s_) * 128) * pitch); \
        _Pragma("unroll") for (int i_ = 0; i_ < 4; ++i_) { \
            __builtin_amdgcn_global_load_lds((const unsigned*)(kg_ + kof[i_]), (LAS unsigned*)(lds + (bf_) * SUPER + OFF_K + (wid * 4 + i_) * 1024), 16, 0, 0); \
            __builtin_amdgcn_global_load_lds((const unsigned*)(vg_ + vof[i_]), (LAS unsigned*)(lds + (bf_) * SUPER + OFF_V + (wid * 4 + i_) * 1024), 16, 0, 0); } } while (0)
        KVDMA(s_lo, 0);
        if (mode == 0) {
            float a0 = 0.f, a1 = 0.f, a2 = 0.f, a3 = 0.f;
            if (4 * tid < 64 * kt_hi) { a0 = lfp[0]; a1 = lfp[8]; a2 = lfp[16]; a3 = lfp[24]; }
            a1 += a0; a2 += a1; a3 += a2;
            float inc = a3;
#pragma unroll
            for (int o_ = 1; o_ < 64; o_ <<= 1) { const float t_ = __shfl_up(inc, o_); if (lane >= o_) inc += t_; }
            if (lane == 63) wsf[0] = inc;
            __syncthreads();
            float base = inc - a3;
            for (int w_ = 0; w_ < wid; ++w_) base += ((LAS float*)(lds + OFF_WS))[w_ * 64];
            *(LAS f32x4*)(biasf + 4 * tid) = (f32x4){-(base + a0) * LOG2E, -(base + a1) * LOG2E, -(base + a2) * LOG2E, -(base + a3) * LOG2E};
        } else {
            if (tid < 384) { const int d = tid - 127; biasf[tid] = (d >= 0 && d <= 128) ? tabp[d] : NEG; }
        }
        asm volatile("s_waitcnt vmcnt(0)" ::: "memory");
        __syncthreads();
        for (int sp = s_lo; sp < s_hi; ++sp) {
            const int buf = (sp - s_lo) & 1;
            if (sp == s_lo && tid == 0) unext = __hip_atomic_fetch_add(qctr, 1u, __ATOMIC_RELAXED, __HIP_MEMORY_SCOPE_AGENT);
            if (sp + 1 < s_hi) KVDMA(sp + 1, buf ^ 1);
            for (int j2 = 0; j2 < 2; ++j2) {
                const int t = 2 * sp + j2, kb = t * KVBLK;
                const bool act = wact && (kb <= qw + 31) && (mode == 0 || kb + 63 >= qw - 128);
                if (act) {
                    f32x16 p0, p1;
                    if (mode == 0) {
                        const LAS float* cb = biasf + kb + 4 * hi;
#pragma unroll
                        for (int q4 = 0; q4 < 4; ++q4) { const f32x4 x0 = *(const LAS f32x4*)(cb + 8 * q4), x1 = *(const LAS f32x4*)(cb + 32 + 8 * q4);
#pragma unroll
                            for (int e = 0; e < 4; ++e) { p0[4 * q4 + e] = x0[e]; p1[4 * q4 + e] = x1[e]; } }
                    } else {
                        const LAS float* tb = biasf + (qw + r32 - kb - 4 * hi + 68);
#pragma unroll
                        for (int r = 0; r < 16; ++r) { const int c = (r & 3) + 8 * (r >> 2); p0[r] = tb[27 - c + 32]; p1[r] = tb[27 - c]; }
                    }
                    qkt(p0, p1, lds + buf * SUPER + OFF_K + j2 * SHM_K, r32, hi, qr);
                    if (mode == 0 && kb + 63 > qw) {
                        const int dq = qw + r32 - kb - 4 * hi;
#pragma unroll
                        for (int r = 0; r < 16; ++r) { const int c = (r & 3) + 8 * (r >> 2); if (dq - c < 0) p0[r] = NEG; if (dq - c - 32 < 0) p1[r] = NEG; }
                    }
                    float alpha; bf16x8 pa0, pa1, pa2, pa3;
                    softmax_tile(p0, p1, m_reg, l_reg, alpha, pa0, pa1, pa2, pa3);
                    if (__any(alpha < 1.f)) { if (hi == 0) wsf[r32] = alpha; asm volatile("s_waitcnt lgkmcnt(0)" ::: "memory");
#pragma unroll
                        for (int r = 0; r < 16; ++r) { const float a_ = wsf[crow(r, hi)];
#pragma unroll
                            for (int d = 0; d < 4; ++d) o[d][r] *= a_; } }
                    pv_tile(o, (int)(uintptr_t)(lds + buf * SUPER + OFF_V + j2 * SHM_V) + v_rd_base(lane), pa0, pa1, pa2, pa3);
                }
            }
            if (sp == s_lo && tid == 0) misc[upar] = unext;
            asm volatile("s_waitcnt vmcnt(0)" ::: "memory");
            __syncthreads();
        }
#undef KVDMA
        if (wact) {
            if (hi == 0) wsf[32 + r32] = l_reg; asm volatile("s_waitcnt lgkmcnt(0)" ::: "memory");
            LAS unsigned char* stg = lds + wid * 8192;
#pragma unroll
            for (int r = 0; r < 16; ++r) { const float il = __builtin_amdgcn_rcpf(wsf[32 + crow(r, hi)]);
#pragma unroll
                for (int d = 0; d < 4; ++d) *(LAS unsigned short*)(stg + crow(r, hi) * 256 + (d * 32 + r32) * 2) = (unsigned short)(cvt_pk_bf16(o[d][r] * il, 0.f) & 0xffffu); }
            asm volatile("s_waitcnt lgkmcnt(0)" ::: "memory");
#pragma unroll
            for (int i = 0; i < 8; ++i) { const int row = (lane >> 4) + 4 * i, ch = lane & 15;
                const u32x4 w = *(const LAS u32x4*)(stg + row * 256 + ch * 16);
                *(u32x4*)(Op + (size_t)(wid * 32 + row) * opitch + ch * 8) = w; }
            if (mode == 1 && hi == 0) *(f32x2*)(MLp + (size_t)(wid * 32 + r32) * mlpitch) = (f32x2){m_reg, l_reg};
        }
    }
}
#undef KSWZ
#undef SBAR
}

__device__ __forceinline__ void merge_phase(const bf16_t* OG, const float* ML, bf16_t* YAB, int wv, int cid) {
    const int gt = (cid >> 3) * (NWAVES * 64) + opaque_tid(wv), NT = ((int)gridDim.x >> 3) * NWAVES * 64;
    for (int it = (cid & 7) * (SEQ * 64) + gt; it < ((cid & 7) + 1) * (SEQ * 64); it += NT) {
        const int row = it >> 6, hs = (it >> 4) & 3, c0 = (it & 15) * 8;
        f32x2 ml[3]; u32x4 ov[3];
#pragma unroll
        for (int g = 0; g < 3; ++g) { ml[g] = *(const f32x2*)(ML + (((size_t)g * M + row) * 4 + hs) * 2); ov[g] = *(const u32x4*)(OG + ((size_t)g * M + row) * 512 + hs * HD + c0); }
        const float mx = fmaxf(fmaxf(ml[0][0], ml[1][0]), ml[2][0]);
        float w[3]; float ws_ = 0.f;
#pragma unroll
        for (int g = 0; g < 3; ++g) { w[g] = ml[g][1] * fast_exp2(ml[g][0] - mx); ws_ += w[g]; }
        const float inv = 1.0f / ws_;
        float y[8];
#pragma unroll
        for (int e = 0; e < 4; ++e) {
            y[2 * e] = (w[0] * bf_lo(ov[0][e]) + w[1] * bf_lo(ov[1][e]) + w[2] * bf_lo(ov[2][e])) * inv;
            y[2 * e + 1] = (w[0] * bf_hi(ov[0][e]) + w[1] * bf_hi(ov[1][e]) + w[2] * bf_hi(ov[2][e])) * inv;
        }
        store_bf16x8(YAB + (size_t)row * YAB_W + hs * HD + c0, y);
    }
}

__device__ __forceinline__ void norm_phase(const bf16_t* src, bf16_t* XB, const float* gpost, const float* gpre, bf16_t* H, float* fout, unsigned char* H8, int wv, int cid) {
    const int tid = opaque_tid(wv), lane = tid & 63, gw = (cid >> 3) * NWAVES + __builtin_amdgcn_readfirstlane(tid >> 6), ngw = ((int)gridDim.x >> 3) * NWAVES, M0 = (cid & 7) * SEQ, M1 = M0 + SEQ;
    f32x4 ga[8], gb[8];
#pragma unroll
    for (int j = 0; j < 8; ++j) { const int ix = 2 * (lane + 64 * (j >> 1)) + (j & 1); ga[j] = *((const f32x4*)gpost + ix); gb[j] = gpre ? *((const f32x4*)gpre + ix) : (f32x4){0.f, 0.f, 0.f, 0.f}; }
    u32x4 sv[4], nsv[4], xw[4], nxw[4];
    int m = M0 + gw;
    if (m < M1) {
#pragma unroll
        for (int c = 0; c < 4; ++c) { sv[c] = *((const u32x4*)(src + (size_t)m * DM) + lane + 64 * c); xw[c] = *((const u32x4*)(XB + (size_t)m * DM) + lane + 64 * c); }
    }
    for (; m < M1; m += ngw) {
        const int mn = m + ngw;
        if (mn < M1) {
#pragma unroll
            for (int c = 0; c < 4; ++c) { nsv[c] = *((const u32x4*)(src + (size_t)mn * DM) + lane + 64 * c); nxw[c] = *((const u32x4*)(XB + (size_t)mn * DM) + lane + 64 * c); }
        }
        f32x4 v[8], xv[8]; float s = 0.f;
#pragma unroll
        for (int j = 0; j < 8; ++j) { const unsigned w0 = sv[j >> 1][2 * (j & 1)], w1 = sv[j >> 1][2 * (j & 1) + 1]; v[j] = (f32x4){bf_lo(w0), bf_hi(w0), bf_lo(w1), bf_hi(w1)};
            s += (v[j][0] * v[j][0] + v[j][1] * v[j][1]) + (v[j][2] * v[j][2] + v[j][3] * v[j][3]); }
        const float r = 1.0f / sqrtf(wave_sum(s) * (1.0f / DM) + EPS);
        float s2 = 0.f;
#pragma unroll
        for (int j = 0; j < 8; ++j) { const unsigned w0 = xw[j >> 1][2 * (j & 1)], w1 = xw[j >> 1][2 * (j & 1) + 1];
            xv[j] = (f32x4){bf_lo(w0), bf_hi(w0), bf_lo(w1), bf_hi(w1)} + v[j] * r * ga[j];
            if (fout) *((f32x4*)(fout + (size_t)m * DM) + 2 * (lane + 64 * (j >> 1)) + (j & 1)) = xv[j];
            s2 += (xv[j][0] * xv[j][0] + xv[j][1] * xv[j][1]) + (xv[j][2] * xv[j][2] + xv[j][3] * xv[j][3]); }
        if (!fout) {
#pragma unroll
            for (int c = 0; c < 4; ++c) { u32x4 w; w.x = cvt_pk_bf16(xv[2 * c][0], xv[2 * c][1]); w.y = cvt_pk_bf16(xv[2 * c][2], xv[2 * c][3]); w.z = cvt_pk_bf16(xv[2 * c + 1][0], xv[2 * c + 1][1]); w.w = cvt_pk_bf16(xv[2 * c + 1][2], xv[2 * c + 1][3]);
                *((u32x4*)(XB + (size_t)m * DM) + lane + 64 * c) = w; }
        }
        if (gpre) {
            const float r2 = 1.0f / sqrtf(wave_sum(s2) * (1.0f / DM) + EPS);
#pragma unroll
            for (int c = 0; c < 4; ++c) { const f32x4 a = xv[2 * c] * r2 * gb[2 * c], b = xv[2 * c + 1] * r2 * gb[2 * c + 1];
                u32x4 w; w.x = cvt_pk_bf16(a[0], a[1]); w.y = cvt_pk_bf16(a[2], a[3]); w.z = cvt_pk_bf16(b[0], b[1]); w.w = cvt_pk_bf16(b[2], b[3]);
                *((u32x4*)(H + (size_t)m * DM) + lane + 64 * c) = w;
                if (H8) { u32x2 q; q.x = pk4_fp8(a[0] * H8_SCALE, a[1] * H8_SCALE, a[2] * H8_SCALE, a[3] * H8_SCALE); q.y = pk4_fp8(b[0] * H8_SCALE, b[1] * H8_SCALE, b[2] * H8_SCALE, b[3] * H8_SCALE);
                    *((u32x2*)(H8 + (size_t)m * DM) + lane + 64 * c) = q; } }
        }
#pragma unroll
        for (int c = 0; c < 4; ++c) { sv[c] = nsv[c]; xw[c] = nxw[c]; }
    }
}
constexpr int PH_PER_LAYER = 10, N_PHASES = 1 + DEPTH * PH_PER_LAYER;
struct Args { const float* in[15]; float* out; unsigned char* ws; int ph_lo, ph_hi; };
__global__ void __launch_bounds__(NWAVES * 64, 2) fwd(Args args) {
    extern __shared__ __attribute__((aligned(16))) unsigned char lds_raw[];
    LAS unsigned char* lds = (LAS unsigned char*)lds_raw;
    const int tid = threadIdx.x;
    const int wv = __builtin_amdgcn_readfirstlane(tid >> 6);
    unsigned char* ws = args.ws;
    Ptrs P;
    P.x = args.in[0]; P.rel_bias = args.in[1]; P.w_in = args.in[2]; P.b_f = args.in[3]; P.w_pa = args.in[4]; P.w_pb = args.in[5]; P.w_o = args.in[6]; P.w_up = args.in[7];
    P.conv_w = args.in[8]; P.conv_b = args.in[9]; P.w_down = args.in[10]; P.g_mix_pre = args.in[11]; P.g_mix_post = args.in[12]; P.g_ffn_pre = args.in[13]; P.g_ffn_post = args.in[14];
    P.out = args.out; P.ws = ws;
    for (int u = tid; u < (LDS_BYTES - LDSCTL_OFF) / 4; u += NWAVES * 64) ((LAS unsigned*)(lds + LDSCTL_OFF))[u] = 0u;
    __syncthreads();
    XcdBarrier bar; bar.bar = (unsigned*)(ws + WS_CTL) + CW_BAR; bar.x = 0; bar.st = nullptr;
#if ONE_LAUNCH
    bar = xcd_barrier_post((unsigned*)(ws + WS_CTL) + CW_BAR, (volatile LAS unsigned*)(lds + MISC_OFF) + 8);
#endif
    const int lo = args.ph_lo, hi = args.ph_hi;
#define IN(k) (lo <= (k) && (k) < hi)
#ifdef ONLY_SITE
#define SITE(s) ((s) == ONLY_SITE)
#else
#define SITE(s) true
#endif
#define SEAM(k) do { if (IN(k) && IN((k) + 1)) xcd_barrier(bar, wv, (k) > 0 && grp, NOREL && (((k) - 1) % PH_PER_LAYER) != 1); } while (0)
#define REP(s) for (int rep_ = 0; rep_ < ((s) == DUP_SITE ? 2 : 1); ++rep_)

    bf16_t* H = (bf16_t*)(ws + WS_H); bf16_t* XBr = (bf16_t*)(ws + WS_XB);
    bf16_t* QKV = (bf16_t*)(ws + WS_QKV); bf16_t* G = (bf16_t*)(ws + WS_G); float* LOGF = (float*)(ws + WS_LOGF); bf16_t* YAB = (bf16_t*)(ws + WS_YAB);
    bf16_t* PA = (bf16_t*)(ws + WS_PA); bf16_t* MERGED = (bf16_t*)(ws + WS_MERGED); bf16_t* MIX = (bf16_t*)(ws + WS_MIX);
    bf16_t* U = (bf16_t*)(ws + WS_U); bf16_t* ACTV = (bf16_t*)(ws + WS_ACTV); bf16_t* Y = (bf16_t*)(ws + WS_Y);
    const float* TAB = (const float*)(ws + WS_TAB);
    bf16_t* OGb = (bf16_t*)(ws + WS_OG); float* MLb = (float*)(ws + WS_ML);
    float* UHb = (float*)(ws + WS_UH); float* UFb = (float*)(ws + WS_UF);

    bool grp = false;
    if (SITE(0) && IN(0)) { REP(0) p0_prologue(P, lds, wv); SEAM(0); }
#if ONE_LAUNCH && BATCH_GROUPS
    grp = __builtin_amdgcn_readfirstlane((int)bar.st[2]) != 0;
    const int cid = grp ? (int)(__builtin_amdgcn_readfirstlane((int)bar.st[3]) * 8 + (int)bar.x) : (int)blockIdx.x;
#else
    const int cid = (int)blockIdx.x;
#endif
    unsigned* wrdy = (unsigned*)(ws + WS_CTL) + CW_WRDY;
#define LATE_CONV(kk) do { if (LATE_CONVERT && layer + 1 < DEPTH && ((cid & 7) >> 1) == (kk)) { \
        asm volatile("s_waitcnt vmcnt(0)" ::: "memory"); __syncthreads(); convert_share(P, lds, layer + 1, wv, cid); } } while (0)
#define LATE_SIG(kk) do { if (LATE_CONVERT && layer + 1 < DEPTH && opaque_tid(wv) == 0) (void)xb_add(wrdy + 16 * (layer + 1), 1u); } while (0)
    for (int layer = 0; layer < DEPTH; ++layer) {
        const int pb = 1 + layer * PH_PER_LAYER;
        if (LATE_CONVERT && layer > 0) {
            if (opaque_tid(wv) == 0) { XB_SPIN(xb_ld(wrdy + 16 * layer) < gridDim.x, bar.bar); __builtin_amdgcn_fence(__ATOMIC_ACQUIRE, "agent"); asm volatile("s_waitcnt vmcnt(0)" ::: "memory"); }
            __syncthreads();
        }
        if (SITE(1) && IN(pb + 0)) {
            { Gemm g{H, DM, (const bf16_t*)(ws + WS_WIN + layer * SZ_WIN), DM, M, N_QKV, DM};
              EpiInProj E{QKV, LOGF, P.b_f + layer * 8};
              REP(1) { flogit_phase(lds, H, (const bf16_t*)(ws + WS_WIN + layer * SZ_WIN) + (size_t)N_QKV * DM, E, wv, cid); run_gemm(lds, g, E, wv, cid); } }
            { Gemm g{(const bf16_t*)(ws + WS_H8), DM, (const bf16_t*)(ws + WS_WIN + layer * SZ_WIN + OFF_WG8), DM, M, N_G, DM};
              EpiGates E{G};
              REP(1) run_gemm<true>(lds, g, E, wv, cid, 1); }
            SEAM(pb + 0);
        }
#if FAST_ATTN
        if (SITE(2) && IN(pb + 1)) { if (LATE_CONVERT && layer + 1 < DEPTH) convert_share(P, lds, layer + 1, wv, cid);
            if (LATE_CONVERT && LATE0 && layer == 0) convert_share(P, lds, 0, wv, cid, cv::I_IN1 + cv::I_IN2, cv::PER_LAYER, CV_WGS);
            REP(2) att::attn_phase(lds, QKV, LOGF, TAB, YAB, OGb, MLb, (unsigned*)(ws + WS_CTL) + CW_Q + 128 * (layer + 4 * rep_), wv, cid); SEAM(pb + 1); LATE_SIG(1);
            if (LATE_CONVERT && LATE0 && layer == 0 && opaque_tid(wv) == 0) (void)xb_add(wrdy, 1u); }
        if (SITE(3) && IN(pb + 2)) { REP(3) merge_phase(OGb, MLb, YAB, wv, cid); SEAM(pb + 2); }
#else
        if (SITE(2) && IN(pb + 1)) { attn_naive(QKV, LOGF, TAB, YAB, wv); SEAM(pb + 1); }
        if (IN(pb + 2)) { SEAM(pb + 2); }
#endif
        if (LATE_CONVERT && LATE0 && layer == 0) {
            if (opaque_tid(wv) == 0) { XB_SPIN(xb_ld(wrdy) < gridDim.x, bar.bar); __builtin_amdgcn_fence(__ATOMIC_ACQUIRE, "agent"); asm volatile("s_waitcnt vmcnt(0)" ::: "memory"); }
            __syncthreads();
        }
        if (SITE(5) && IN(pb + 3)) {
            Gemm g{YAB, YAB_W, (const bf16_t*)(ws + WS_WPA + layer * SZ_WPAB), YAB_W, M, DM, YAB_W};
            EpiPaPb E{G, MERGED};
            REP(5) run_gemm(lds, g, E, wv, cid); SEAM(pb + 3);
        }
        if (SITE(6) && IN(pb + 4)) {
            Gemm g{MERGED, DM, (const bf16_t*)(ws + WS_WO + layer * SZ_WO), DM, M, DM, DM};
            EpiBf16 E{MIX, DM};
            REP(6) run_gemm(lds, g, E, wv, cid); SEAM(pb + 4);
        }
        if (SITE(7) && IN(pb + 5)) { norm_phase(MIX, XBr, P.g_mix_post + layer * DM, P.g_ffn_pre + layer * DM, H, nullptr, nullptr, wv, cid); SEAM(pb + 5); }
        if (SITE(8) && IN(pb + 6)) {
            Gemm g{H, DM, (const bf16_t*)(ws + WS_WUP + layer * SZ_WUP), DM, M, N_UP, DM};
            EpiConv E{P.conv_w + (size_t)layer * 3 * N_UP, P.conv_b + (size_t)layer * N_UP, ACTV, UHb, UFb};
            REP(8) run_gemm(lds, g, E, wv, cid); SEAM(pb + 6);
        }
#if !FIX_LOCAL
        if (SITE(9) && IN(pb + 7)) { REP(9) fixup_phase(UHb, UFb, P.conv_w + (size_t)layer * 3 * N_UP, P.conv_b + (size_t)layer * N_UP, ACTV, wv); SEAM(pb + 7); }
#endif
        if (SITE(10) && IN(pb + 8)) {
            Gemm g{ACTV, DFF, (const bf16_t*)(ws + WS_WDN + layer * SZ_WDN), DFF, M, DM, DFF};
            EpiBf16 E{Y, DM};
#if FIX_LOCAL
            fixup_local(UHb, UFb, P.conv_w + (size_t)layer * 3 * N_UP, P.conv_b + (size_t)layer * N_UP, ACTV, wv, cid);
#endif
            REP(10) run_gemm(lds, g, E, wv, cid); SEAM(pb + 8);
        }
        if (SITE(11) && IN(pb + 9)) {
            norm_phase(Y, XBr, P.g_ffn_post + layer * DM, layer + 1 < DEPTH ? P.g_mix_pre + (layer + 1) * DM : nullptr, H, layer + 1 < DEPTH ? nullptr : P.out, ws + WS_H8, wv, cid);
            SEAM(pb + 9);
        }
    }
#undef IN
#undef SEAM
#undef LATE_CONV
#undef LATE_SIG
}

extern "C" void kernel_launch(void* const* d_in, const int* in_sizes, int n_in, void* d_out, int out_size, void* d_ws, size_t ws_size, hipStream_t stream) {
    static int grid = 0;
    if (grid == 0) {
        if (n_in != 15 || out_size != M * DM || ws_size < WS_END) { fprintf(stderr, "kernel_launch: unexpected shapes (n_in %d out %d ws %zu need %zu)\n", n_in, out_size, ws_size, (size_t)WS_END); grid = -1; return; }
        int dev = 0, cus = 0, per_cu = 0;
        if (hipGetDevice(&dev) != hipSuccess || hipDeviceGetAttribute(&cus, hipDeviceAttributeMultiprocessorCount, dev) != hipSuccess) { grid = -1; return; }
        if (hipFuncSetAttribute((const void*)fwd, hipFuncAttributeMaxDynamicSharedMemorySize, LDS_BYTES) != hipSuccess) { fprintf(stderr, "kernel_launch: hipFuncSetAttribute failed\n"); grid = -1; return; }
        if (hipOccupancyMaxActiveBlocksPerMultiprocessor(&per_cu, (const void*)fwd, NWAVES * 64, LDS_BYTES) != hipSuccess || per_cu < 1) { fprintf(stderr, "kernel_launch: occupancy query says %d\n", per_cu); }
        (void)hipGetLastError();
        grid = cus;
    }
    if (grid < 0) return;
    (void)hipMemsetAsync((char*)d_ws + WS_CTL, 0, CTL_ZERO_BYTES, stream);
    Args a{};
    for (int i = 0; i < 15; ++i) a.in[i] = (const float*)d_in[i];
    a.out = (float*)d_out; a.ws = (unsigned char*)d_ws;
#if ONE_LAUNCH
    a.ph_lo = 0; a.ph_hi = N_PHASES;
    hipLaunchKernelGGL(fwd, dim3(grid), dim3(NWAVES * 64), LDS_BYTES, stream, a);
#else
    for (int p = 0; p < N_PHASES; ++p) { a.ph_lo = p; a.ph_hi = p + 1; hipLaunchKernelGGL(fwd, dim3(grid), dim3(NWAVES * 64), LDS_BYTES, stream, a); }
#endif
}
```

```cpp
#include <hip/hip_runtime.h>
#include <cstdio>
#include <cstdint>

#ifndef FAST_GEMM
#define FAST_GEMM 1
#endif
#ifndef FAST_ATTN
#define FAST_ATTN 1
#endif
#ifndef GEMM_ALIGN
#define GEMM_ALIGN true
#endif
#ifndef MID_B
#define MID_B 4
#endif
#ifndef FIX_LOCAL
#define FIX_LOCAL 1
#endif
#ifndef BATCH_GROUPS
#define BATCH_GROUPS 1
#endif
#ifndef LATE_CONVERT
#define LATE_CONVERT 1
#endif
#ifndef CV_WGS
#define CV_WGS 8
#endif
#ifndef NOREL
#define NOREL 1
#endif
#ifndef LATE0
#define LATE0 1
#endif
#ifndef GEMM_SP2
#define GEMM_SP2 true
#endif
#ifndef DUP_SITE
#define DUP_SITE -1
#endif
#ifndef ONE_LAUNCH
#define ONE_LAUNCH 1
#endif

#define GAS __attribute__((address_space(1)))
#define LAS __attribute__((address_space(3)))
typedef unsigned short bf16_t;
typedef short bf16x8 __attribute__((ext_vector_type(8)));
typedef float f32x4 __attribute__((ext_vector_type(4)));
typedef float f32x2 __attribute__((ext_vector_type(2)));
typedef unsigned u32x4 __attribute__((ext_vector_type(4)));
typedef unsigned u32x2 __attribute__((ext_vector_type(2)));

constexpr int BATCH = 8, SEQ = 2048, DM = 2048, DEPTH = 4, HD = 128;
constexpr int M = BATCH * SEQ;
constexpr int N_A = 4608, N_QKV = 7680, N_IN = 11784, N_INP = 12032, N_G = 4096;
constexpr int N_P1 = N_QKV + 256;
constexpr float H8_SCALE = 16.f, W8_SCALE = 512.f;
constexpr int YAB_W = 1536;
constexpr int DFF = 5632, N_UP = 2 * DFF;
constexpr float EPS = 1e-6f;
constexpr float LOG2E = 1.4426950408889634f;
constexpr float QSCALE = 0.08838834764831845f * LOG2E;
constexpr int NWAVES = 8;

constexpr size_t MiB = 1u << 20;
constexpr size_t WS_CTL = 0, CTL_ZERO_BYTES = 1 * MiB;
constexpr size_t WS_TAB = 1 * MiB;
constexpr size_t WS_WIN = 2 * MiB,   SZ_WIN = (size_t)N_INP * DM * 2;
constexpr size_t WS_WPA = 190 * MiB, SZ_WPA = (size_t)DM * 512 * 2, SZ_WPAB = (size_t)DM * YAB_W * 2;
constexpr size_t WS_WPB = 198 * MiB, SZ_WPB = (size_t)DM * 1024 * 2;
constexpr size_t WS_WO  = 214 * MiB, SZ_WO  = (size_t)DM * DM * 2;
constexpr size_t WS_WUP = 246 * MiB, SZ_WUP = (size_t)N_UP * DM * 2;
constexpr size_t WS_WDN = 422 * MiB, SZ_WDN = (size_t)DM * DFF * 2;
constexpr size_t WS_H   = 510 * MiB;
constexpr size_t WS_ACT0 = 574 * MiB;
constexpr size_t WS_QKV = WS_ACT0, WS_PA = WS_ACT0;
constexpr size_t WS_G = WS_ACT0 + 240 * MiB;
constexpr size_t WS_MIX = WS_ACT0 + 368 * MiB;
constexpr size_t WS_LOGF = WS_ACT0 + 432 * MiB;
constexpr size_t WS_YAB = WS_ACT0 + 433 * MiB;
constexpr size_t WS_OG = WS_ACT0 + 481 * MiB;
constexpr size_t WS_ML = WS_ACT0 + 529 * MiB;
constexpr size_t WS_MERGED = WS_ACT0 + 531 * MiB;
constexpr size_t WS_U = WS_ACT0, WS_Y = WS_MERGED;
constexpr size_t WS_UH = WS_ACT0 + 595 * MiB, WS_UF = WS_ACT0 + 601 * MiB;
constexpr size_t WS_ACTV = WS_ACT0 + 607 * MiB;
constexpr size_t WS_XB = WS_ACT0 + 783 * MiB;
constexpr size_t WS_H8 = WS_XB + 64 * MiB;
constexpr size_t WS_END = WS_H8 + 32 * MiB;
static_assert(WS_QKV + (size_t)M * N_QKV * 2 <= WS_G && WS_G + (size_t)M * N_G * 2 <= WS_MIX && WS_MIX + (size_t)M * DM * 2 <= WS_LOGF && WS_LOGF + (size_t)M * 8 * 4 <= WS_YAB &&
              WS_YAB + (size_t)M * YAB_W * 2 <= WS_OG && WS_OG + (size_t)3 * M * 512 * 2 <= WS_ML && WS_ML + (size_t)3 * M * 8 * 4 <= WS_MERGED && WS_MERGED + (size_t)M * DM * 2 <= WS_UH &&
              WS_UH + (size_t)64 * 2 * N_UP * 4 <= WS_UF && WS_UF + (size_t)64 * 2 * N_UP * 4 <= WS_ACTV && WS_ACTV + (size_t)M * DFF * 2 <= WS_XB, "activation map: no overlaps");
constexpr size_t OFF_WG8 = (size_t)N_P1 * DM * 2;
static_assert(OFF_WG8 + (size_t)N_G * DM <= SZ_WIN, "gate weights fit");
static_assert(WS_WIN + 4 * SZ_WIN <= WS_WPA && WS_WPA + 4 * SZ_WPA <= WS_WPB && WS_WPB + 4 * SZ_WPB <= WS_WO && WS_WO + 4 * SZ_WO <= WS_WUP && WS_WUP + 4 * SZ_WUP <= WS_WDN && WS_WDN + 4 * SZ_WDN <= WS_H, "weights map");
static_assert(WS_H + (size_t)M * DM * 2 <= WS_ACT0 && WS_ACTV + (size_t)M * DFF * 2 <= WS_END, "act map");
constexpr int CW_BAR = 4096, CW_Q = 8192, CW_WRDY = 12288;

constexpr int RING_BYTES = 131072;
constexpr int LDSCTL_OFF = RING_BYTES, MISC_OFF = LDSCTL_OFF + 320;
constexpr int HALO_OFF = MISC_OFF + 128;
constexpr int LDS_BYTES = 147456;
static_assert(HALO_OFF % 16 == 0 && HALO_OFF + 8192 + 4096 <= LDS_BYTES, "LDS map");

__device__ __forceinline__ unsigned cvt_pk_bf16(float lo, float hi) { unsigned r; asm volatile("v_cvt_pk_bf16_f32 %0, %1, %2" : "=v"(r) : "v"(lo), "v"(hi)); return r; }
__device__ __forceinline__ float bf_lo(unsigned w) { return __uint_as_float(w << 16); }
__device__ __forceinline__ float bf_hi(unsigned w) { return __uint_as_float(w & 0xffff0000u); }
__device__ __forceinline__ float wave_sum(float v) {
#pragma unroll
    for (int o = 1; o < 64; o <<= 1) v += __shfl_xor(v, o);
    return v;
}
__device__ __forceinline__ int opaque_tid(int wv) {
    int l; asm volatile("v_mbcnt_lo_u32_b32 %0, -1, 0\n\tv_mbcnt_hi_u32_b32 %0, -1, %0" : "=v"(l));
    return wv * 64 + l; }
__device__ __forceinline__ float fast_exp2(float x) { return __builtin_amdgcn_exp2f(x); }
__device__ __forceinline__ float sigmoidf_(float x) { return __builtin_amdgcn_rcpf(1.0f + fast_exp2(-x * LOG2E)); }
__device__ __forceinline__ int t5_bucket(int dist) {
    if (dist < 16) return dist;
    int b = 16;
    b += (dist >= 22); b += (dist >= 30); b += (dist >= 40); b += (dist >= 54); b += (dist >= 73); b += (dist >= 99); b += (dist >= 134); b += (dist >= 182);
    b += (dist >= 246); b += (dist >= 332); b += (dist >= 450); b += (dist >= 609); b += (dist >= 825); b += (dist >= 1117); b += (dist >= 1513);
    return b;
}

#define XB_TMO      128
#define XB_XCNT(j)  (256  + 64 * (j))
#define XB_XSUB(j)  (1280 + 64 * (j))
#define XB_XGEN(j)  (2304 + 64 * (j))
#define XB_TOP      3328
#define XB_TOPGEN   3392
#define XCD_BAR_WORDS 3456
#define XB_SPIN_CAP (1u << 18)
__device__ __forceinline__ unsigned xb_ld(unsigned* p)              { return __hip_atomic_load(p, __ATOMIC_RELAXED, __HIP_MEMORY_SCOPE_AGENT); }
__device__ __forceinline__ unsigned xb_add(unsigned* p, unsigned v) { return __hip_atomic_fetch_add(p, v, __ATOMIC_RELAXED, __HIP_MEMORY_SCOPE_AGENT); }
__device__ __forceinline__ unsigned xb_xcc_id() { return (unsigned)__builtin_amdgcn_s_getreg((3 << 11) | 20) & 0xFu; }
#define XB_SPIN(cond, bar) do { unsigned _sp = 0; while (cond) { __builtin_amdgcn_s_sleep(1); \
    if ((++_sp & 255u) == 0u) { if (xb_ld(&(bar)[XB_TMO])) break; if (_sp > XB_SPIN_CAP) { atomicAdd(&(bar)[XB_TMO], 1u); break; } } } } while (0)
struct XcdBarrier { unsigned* bar; unsigned x; volatile LAS unsigned* st; };
__device__ __forceinline__ XcdBarrier xcd_barrier_post(unsigned* bar, volatile LAS unsigned* st) {
    XcdBarrier b; b.bar = bar; b.x = xb_xcc_id(); b.st = st;
    if (threadIdx.x == 0) st[3] = xb_add(&bar[XB_XCNT(b.x)], 1u);
    return b;
}
__device__ __forceinline__ void xcd_barrier_complete(unsigned* bar, unsigned x, unsigned& nloc, unsigned& nx, unsigned& even) {
    const unsigned G = gridDim.x * gridDim.y * gridDim.z;
    unsigned sum, cnt, mine, sp = 0u; even = 0u;
    for (;;) {
        sum = 0u; cnt = 0u; mine = 0u; unsigned ok8 = 1u;
#pragma unroll
        for (unsigned j = 0; j < 16; ++j) { const unsigned c = xb_ld(&bar[XB_XCNT(j)]); sum += c; cnt += (c > 0u) ? 1u : 0u; mine = (j == x) ? c : mine; ok8 &= (j < 8u) ? (c == 32u ? 1u : 0u) : (c == 0u ? 1u : 0u); }
        even = ok8;
        if (sum == G) break;
        __builtin_amdgcn_s_sleep(1);
        if ((++sp & 255u) == 0u) { if (xb_ld(&bar[XB_TMO])) break; if (sp > XB_SPIN_CAP) { atomicAdd(&bar[XB_TMO], 1u); break; } }
    }
    nloc = mine > 0u ? mine : 1u; nx = cnt > 0u ? cnt : 1u;
}
__device__ __forceinline__ void xcd_barrier(const XcdBarrier& b, int wv, bool local = false, bool norel = false) {
    asm volatile("s_waitcnt vmcnt(0)" ::: "memory");
    __syncthreads();
    if (opaque_tid(wv) == 0) {
        unsigned* bar = b.bar;
        __builtin_amdgcn_s_waitcnt(0);
        unsigned nloc = b.st[0], nx = b.st[1];
        if (nloc == 0u) { unsigned ev; xcd_barrier_complete(bar, b.x, nloc, nx, ev); b.st[0] = nloc; b.st[1] = nx; b.st[2] = ev; }
        const unsigned old = xb_add(&bar[XB_XSUB(b.x)], 1u);
        const unsigned gen = old / nloc;
        if (old + 1u == (gen + 1u) * nloc) {
            if (!(local && norel)) __builtin_amdgcn_fence(__ATOMIC_RELEASE, "agent");
            asm volatile("s_waitcnt vmcnt(0)" ::: "memory");
            if (!local) {
            const unsigned og = xb_add(&bar[XB_TOP], 1u);
            const unsigned tg = og / nx;
            if (og + 1u == (tg + 1u) * nx) xb_add(&bar[XB_TOPGEN], 1u);
            else XB_SPIN(xb_ld(&bar[XB_TOPGEN]) == tg, bar);
            }
            __builtin_amdgcn_fence(__ATOMIC_ACQUIRE, "agent");
            xb_add(&bar[XB_XGEN(b.x)], 1u);
            asm volatile("s_waitcnt vmcnt(0)" ::: "memory");
        } else {
            XB_SPIN(xb_ld(&bar[XB_XGEN(b.x)]) == gen, bar);
            __builtin_amdgcn_fence(__ATOMIC_ACQUIRE, "agent");
            asm volatile("s_waitcnt vmcnt(0)" ::: "memory");
        }
    }
    __syncthreads();
}

__host__ __device__ __forceinline__ int perm32(int rho) { const int n = rho >> 4, i = rho & 15; return 8 * (i >> 2) + 4 * n + (i & 3); }
struct Gemm { const bf16_t* A; int lda; const bf16_t* Bt; int ldb; int M, N, K; };

template <class Epi>
__device__ __forceinline__ void gemm_naive(const Gemm g, const Epi& E, int gw, int ngw, int lane) {
    const int fr = lane & 15, fq = lane >> 4;
    const int ntn = g.N / 64, ntm = g.M / 64;
    for (int tile = gw; tile < ntn * ntm; tile += ngw) {
        const int tm = tile / ntn, tn = tile % ntn;
        f32x4 acc[4][2][2];
#pragma unroll
        for (int m = 0; m < 4; ++m)
#pragma unroll
            for (int q = 0; q < 2; ++q)
#pragma unroll
                for (int n = 0; n < 2; ++n) acc[m][q][n] = (f32x4){0.f, 0.f, 0.f, 0.f};
        const bf16_t* ap = g.A + (size_t)(tm * 64 + fr) * g.lda + fq * 8;
        const bf16_t* bp0 = g.Bt + (size_t)(tn * 64 + perm32(fr)) * g.ldb + fq * 8;
        const bf16_t* bp1 = g.Bt + (size_t)(tn * 64 + perm32(16 + fr)) * g.ldb + fq * 8;
        for (int k0 = 0; k0 < g.K; k0 += 32) {
            bf16x8 af[4], bf[2][2];
#pragma unroll
            for (int m = 0; m < 4; ++m) af[m] = *(const bf16x8*)(ap + (size_t)(16 * m) * g.lda + k0);
#pragma unroll
            for (int q = 0; q < 2; ++q) { bf[q][0] = *(const bf16x8*)(bp0 + (size_t)(32 * q) * g.ldb + k0); bf[q][1] = *(const bf16x8*)(bp1 + (size_t)(32 * q) * g.ldb + k0); }
#pragma unroll
            for (int m = 0; m < 4; ++m)
#pragma unroll
                for (int q = 0; q < 2; ++q)
#pragma unroll
                    for (int n = 0; n < 2; ++n) acc[m][q][n] = __builtin_amdgcn_mfma_f32_16x16x32_bf16(bf[q][n], af[m], acc[m][q][n], 0, 0, 0);
        }
        const int ctile = __builtin_amdgcn_readfirstlane((tn * 64) >> 8);
#pragma unroll
        for (int m = 0; m < 4; ++m)
#pragma unroll
            for (int q = 0; q < 2; ++q) {
                const float v[8] = {acc[m][q][0][0], acc[m][q][0][1], acc[m][q][0][2], acc[m][q][0][3], acc[m][q][1][0], acc[m][q][1][1], acc[m][q][1][2], acc[m][q][1][3]};
                E(tm * 64 + 16 * m + fr, tn * 64 + 32 * q + 8 * fq, v, ctile);
            }
    }
}

template <class E> __device__ constexpr bool epi_has_pre() { if constexpr (E::TILE) return E::PRE; else return false; }
namespace pg8 { struct Unit { int pm, pn; }; }
__device__ __forceinline__ void store_bf16x8(bf16_t* p, const float (&v)[8]) {
    u32x4 w; w.x = cvt_pk_bf16(v[0], v[1]); w.y = cvt_pk_bf16(v[2], v[3]); w.z = cvt_pk_bf16(v[4], v[5]); w.w = cvt_pk_bf16(v[6], v[7]);
    *(u32x4*)p = w;
}
struct EpiInProj {
    static constexpr bool TILE = false, MID = false;
    bf16_t* QKV; float* LOGF; const float* bf;
    __device__ __forceinline__ void operator()(int row, int col0, const float (&v)[8], int ctile) const {
        if (ctile < 30) {
            const bool isq = (ctile < 6) || (ctile >= 18 && ctile < 22);
            const float sc = isq ? QSCALE : 1.0f;
            const float w[8] = {v[0] * sc, v[1] * sc, v[2] * sc, v[3] * sc, v[4] * sc, v[5] * sc, v[6] * sc, v[7] * sc};
            store_bf16x8(QKV + (size_t)row * N_QKV + col0, w);
        } else if (col0 == N_QKV) {
            float w[8];
#pragma unroll
            for (int j = 0; j < 8; ++j) { const float z = v[j] + bf[j]; w[j] = fminf(z, 0.f) - log1pf(expf(-fabsf(z))); }
            *(f32x4*)(LOGF + (size_t)row * 8) = (f32x4){w[0], w[1], w[2], w[3]};
            *(f32x4*)(LOGF + (size_t)row * 8 + 4) = (f32x4){w[4], w[5], w[6], w[7]};
        }
    }
};
struct EpiGates {
    static constexpr bool TILE = true, MID = false, PRE = false;
    bf16_t* G;
    __device__ __forceinline__ void tile(const f32x4 (&acc)[2][2][4][2], const pg8::Unit& u, int wr, int wc, int fr, int fq, LAS unsigned char*) const {
        constexpr float ninv = -LOG2E / (H8_SCALE * W8_SCALE);
#pragma unroll
        for (int ai = 0; ai < 2; ++ai)
#pragma unroll
            for (int m = 0; m < 4; ++m) {
                float r[8], gb[8];
#pragma unroll
                for (int e = 0; e < 8; e += 2) {
                    const f32x2 za = (f32x2){acc[ai][0][m][e >> 2][e & 3], acc[ai][0][m][e >> 2][(e & 3) + 1]} * ninv, zb = (f32x2){acc[ai][1][m][e >> 2][e & 3], acc[ai][1][m][e >> 2][(e & 3) + 1]} * ninv;
                    const f32x2 da = (f32x2){fast_exp2(za[0]), fast_exp2(za[1])} + 1.0f, db = (f32x2){fast_exp2(zb[0]), fast_exp2(zb[1])} + 1.0f;
                    r[e] = fminf(db[0], 1e20f) * __builtin_amdgcn_rcpf(da[0]); r[e + 1] = fminf(db[1], 1e20f) * __builtin_amdgcn_rcpf(da[1]);
                    gb[e] = __builtin_amdgcn_rcpf(db[0]); gb[e + 1] = __builtin_amdgcn_rcpf(db[1]);
                }
                bf16_t* gp = G + (size_t)(u.pm * 256 + ai * 128 + wr * 64 + m * 16 + fr) * N_G + u.pn * 128 + wc * 32 + 8 * fq;
                store_bf16x8(gp, r); store_bf16x8(gp + DM, gb);
            }
    }
};
struct EpiF32 {
    static constexpr bool TILE = false, MID = false;
    float* C; int ldc;
    __device__ __forceinline__ void operator()(int row, int col0, const float (&v)[8], int) const {
        float* p = C + (size_t)row * ldc + col0;
        *(f32x4*)p = (f32x4){v[0], v[1], v[2], v[3]}; *(f32x4*)(p + 4) = (f32x4){v[4], v[5], v[6], v[7]};
    }
};
struct EpiBf16 {
    static constexpr bool TILE = false, MID = false;
    bf16_t* O; int ldc;
    __device__ __forceinline__ void operator()(int row, int col0, const float (&v)[8], int) const { store_bf16x8(O + (size_t)row * ldc + col0, v); }
};
struct EpiMerge {
    static constexpr bool TILE = false, MID = false;
    const bf16_t* PA; const bf16_t* G; bf16_t* O;
    __device__ __forceinline__ void operator()(int row, int col0, const float (&v)[8], int) const {
        const u32x4 pa = *(const u32x4*)(PA + (size_t)row * DM + col0);
        const u32x4 ga = *(const u32x4*)(G + (size_t)row * N_G + col0), gb = *(const u32x4*)(G + (size_t)row * N_G + DM + col0);
        float w[8];
#pragma unroll
        for (int e = 0; e < 4; ++e) { w[2 * e] = bf_lo(ga[e]) * bf_lo(pa[e]) + bf_lo(gb[e]) * v[2 * e]; w[2 * e + 1] = bf_hi(ga[e]) * bf_hi(pa[e]) + bf_hi(gb[e]) * v[2 * e + 1]; }
        store_bf16x8(O + (size_t)row * DM + col0, w);
    }
};

struct EpiPaPb {
    static constexpr bool TILE = true, MID = true, PRE = false; static constexpr int MID_T = 512 / 64;
    const bf16_t* G; bf16_t* O;
    __device__ __forceinline__ void mid(f32x4 (&acc)[2][2][4][2], const pg8::Unit& u, int wr, int wc, int fr, int fq) const {
        asm volatile("" : "+v"(fr), "+v"(fq));
        u32x4 rr[2][4][2];
#pragma unroll
        for (int ai = 0; ai < 2; ++ai)
#pragma unroll
            for (int m = 0; m < 4; ++m)
#pragma unroll
                for (int bj = 0; bj < 2; ++bj)
                    rr[ai][m][bj] = *(const u32x4*)(G + (size_t)(u.pm * 256 + ai * 128 + wr * 64 + m * 16 + fr) * N_G + u.pn * 256 + bj * 128 + wc * 32 + 8 * fq);
        asm volatile("s_waitcnt vmcnt(0)" ::: "memory");
#pragma unroll
        for (int ai = 0; ai < 2; ++ai)
#pragma unroll
            for (int m = 0; m < 4; ++m)
#pragma unroll
                for (int bj = 0; bj < 2; ++bj) {
                    asm volatile("" : "+v"(rr[ai][m][bj]));
#pragma unroll
                    for (int e = 0; e < 4; ++e) { acc[ai][bj][m][e >> 1][(e & 1) * 2] *= bf_lo(rr[ai][m][bj][e]); acc[ai][bj][m][e >> 1][(e & 1) * 2 + 1] *= bf_hi(rr[ai][m][bj][e]); }
                }
    }
    __device__ __forceinline__ void tile(const f32x4 (&acc)[2][2][4][2], const pg8::Unit& u, int wr, int wc, int fr, int fq, LAS unsigned char*) const {
        u32x4 gb[2][4][2];
#pragma unroll
        for (int ai = 0; ai < 2; ++ai)
#pragma unroll
            for (int m = 0; m < 4; ++m)
#pragma unroll
                for (int bj = 0; bj < 2; ++bj)
                    gb[ai][m][bj] = *(const u32x4*)(G + (size_t)(u.pm * 256 + ai * 128 + wr * 64 + m * 16 + fr) * N_G + DM + u.pn * 256 + bj * 128 + wc * 32 + 8 * fq);
        asm volatile("s_waitcnt vmcnt(0)" ::: "memory");
#pragma unroll
        for (int ai = 0; ai < 2; ++ai)
#pragma unroll
            for (int m = 0; m < 4; ++m)
#pragma unroll
                for (int bj = 0; bj < 2; ++bj) {
                    asm volatile("" : "+v"(gb[ai][m][bj]));
                    const float v[8] = {acc[ai][bj][m][0][0], acc[ai][bj][m][0][1], acc[ai][bj][m][0][2], acc[ai][bj][m][0][3], acc[ai][bj][m][1][0], acc[ai][bj][m][1][1], acc[ai][bj][m][1][2], acc[ai][bj][m][1][3]};
                    float w[8];
#pragma unroll
                    for (int e = 0; e < 4; ++e) { w[2 * e] = v[2 * e] * fmaxf(bf_lo(gb[ai][m][bj][e]), 1e-20f); w[2 * e + 1] = v[2 * e + 1] * fmaxf(bf_hi(gb[ai][m][bj][e]), 1e-20f); }
                    store_bf16x8(O + (size_t)(u.pm * 256 + ai * 128 + wr * 64 + m * 16 + fr) * DM + u.pn * 256 + bj * 128 + wc * 32 + 8 * fq, w);
                }
    }
    __device__ __forceinline__ void operator()(int row, int col0, const float (&v)[8], int) const {
        const u32x4 gb = *(const u32x4*)(G + (size_t)row * N_G + DM + col0);
        float w[8];
#pragma unroll
        for (int e = 0; e < 4; ++e) { w[2 * e] = v[2 * e] * fmaxf(bf_lo(gb[e]), 1e-20f); w[2 * e + 1] = v[2 * e + 1] * fmaxf(bf_hi(gb[e]), 1e-20f); }
        store_bf16x8(O + (size_t)row * DM + col0, w);
    }
};

namespace pg8 {
constexpr int BM = 256, BK = 64, HALF = 128, HTB = HALF * BK * 2, STAGE_BYTES = 8 * HTB, NXCD = 8, WGM = 8;
__host__ __device__ __forceinline__ int lds_byte(int r, int c) { const int st = (r >> 4) * 2 + (c >> 5), rr = r & 15, cc = c & 31, ob = rr * 64 + cc * 2; return st * 1024 + (ob ^ (((ob >> 9) & 1) << 5)); }
__host__ __device__ __forceinline__ void stage_rc(int b, int& R, int& C) { const int st = b / 1024, sb = b % 1024, swz = sb ^ (((sb >> 9) & 1) << 5); R = (st >> 1) * 16 + swz / 64; C = (st & 1) * 32 + (swz % 64) / 2; }
struct StaticOrder {
    int nM, nN, nwg, G, c, split;
    __host__ __device__ void init(int M_, int N_, int G_, int c_) { nM = M_ / BM; nN = N_ / BM; nwg = nM * nN; G = G_; c = c_; split = 0; }
    __host__ __device__ bool next(int i, Unit& u) const {
        long L;
        if (!split) { L = (long)i * G + c; if (L >= nwg) return false; }
        else {
            if (i < 3) L = (long)i * G + c; else if (c >= G / 2 && i < 5) L = 3L * G + (long)(i - 3) * (G / 2) + (c - G / 2); else return false;
        }
        int wgid = (int)L; { const int q = nwg / NXCD, r = nwg % NXCD, xcd = wgid % NXCD, off = wgid / NXCD; wgid = (xcd < r ? xcd * (q + 1) : r * (q + 1) + (xcd - r) * q) + off; }
        const int nig = WGM * nN, gid = wgid / nig, fm = gid * WGM, gsz = (nM - fm) < WGM ? (nM - fm) : WGM;
        u.pm = fm + ((wgid % nig) % gsz); u.pn = (wgid % nig) / gsz; return true;
    }
};
template <class Epi>
__device__ __forceinline__ void run_epi(const Epi& E, const f32x4 (&acc)[2][2][4][2], const Unit& u, int wr, int wc, int fr, int fq) {
#pragma unroll
    for (int ai = 0; ai < 2; ++ai)
#pragma unroll
        for (int m = 0; m < 4; ++m)
#pragma unroll
            for (int bj = 0; bj < 2; ++bj) {
                const float v[8] = {acc[ai][bj][m][0][0], acc[ai][bj][m][0][1], acc[ai][bj][m][0][2], acc[ai][bj][m][0][3], acc[ai][bj][m][1][0], acc[ai][bj][m][1][1], acc[ai][bj][m][1][2], acc[ai][bj][m][1][3]};
                E(u.pm * BM + ai * HALF + wr * 64 + m * 16 + fr, u.pn * BM + bj * HALF + wc * 32 + 8 * fq, v, u.pn);
            }
}
typedef int v8i32 __attribute__((ext_vector_type(8)));
typedef int v4i32 __attribute__((ext_vector_type(4)));
__device__ __forceinline__ v8i32 cat16(bf16x8 a, bf16x8 b) { const v4i32 x = __builtin_bit_cast(v4i32, a), y = __builtin_bit_cast(v4i32, b); return __builtin_shufflevector(x, y, 0, 1, 2, 3, 4, 5, 6, 7); }
template <class Epi, bool ALIGN_EPI = true, bool SP2 = true, bool F8 = false>
__device__ __forceinline__ void gemm_phase(LAS unsigned char* lds, const Gemm g, const StaticOrder& S, const Epi& E, int wv) {
    const int tid = opaque_tid(wv), wid = __builtin_amdgcn_readfirstlane(tid >> 6), lane = tid & 63, wr = wid >> 2, wc = wid & 3, fr = lane & 15, fq = lane >> 4;
    constexpr int ESZ = F8 ? 1 : 2; const int nt = g.K * ESZ / (BK * 2);
    unsigned voffA[2], voffB[2];
#pragma unroll
    for (int i = 0; i < 2; ++i) { int R, C; stage_rc(tid * 16 + i * 8192, R, C); const int Rb = (R & ~31) + perm32(R & 31);
        voffA[i] = (unsigned)(R * g.lda * ESZ + C * 2); voffB[i] = (unsigned)(Rb * g.ldb * ESZ + C * 2); }
    const size_t kstep = (size_t)(BK * 2);
    const size_t hstepA = (size_t)HALF * g.lda * ESZ, hstepB = (size_t)HALF * g.ldb * ESZ;
    const size_t tstepA = 2 * hstepA, tstepB = 2 * hstepB;
    const unsigned ldsw = (unsigned)wid * 1024u;
    const int aoff = lds_byte(wr * 64 + fr, fq * 8), boff = lds_byte(wc * 32 + fr, fq * 8);
#define PG8_SA(b, h) (((b) * 2 + (h)) * HTB)
#define PG8_SB(b, h) ((4 + (b) * 2 + (h)) * HTB)
#define PG8_STAGE(bufoff, gbase, voff) do { _Pragma("unroll") for (int _i = 0; _i < 2; ++_i) \
        __builtin_amdgcn_global_load_lds((const unsigned*)((const char*)(gbase) + (voff)[_i]), (LAS unsigned*)(lds + (bufoff) + ldsw + _i * 8192), 16, 0, 0); } while (0)
#define PG8_ASMRD(dst_, base_, off_) asm volatile("ds_read_b128 %0, %1 offset:%2" : "=&v"(dst_) : "v"(base_), "i"(off_) : "memory")
#define PG8_LDA(dst, b, h) do { _Pragma("unroll") for (int m = 0; m < 4; ++m) { if constexpr (F8) dst##8[m] = cat16(*(const LAS bf16x8*)(lds + PG8_SA(b, h) + aoff + m * 2048), *(const LAS bf16x8*)(lds + PG8_SA(b, h) + aoff + m * 2048 + 1024)); \
        else { const int ab_ = (int)(uintptr_t)(lds + PG8_SA(b, h) + aoff); _Pragma("unroll") for (int k = 0; k < 2; ++k) PG8_ASMRD(dst[m][k], ab_, m * 2048 + k * 1024); } } } while (0)
#define PG8_LDB(dst, b, h) do { _Pragma("unroll") for (int n = 0; n < 2; ++n) { if constexpr (F8) dst##8[n] = cat16(*(const LAS bf16x8*)(lds + PG8_SB(b, h) + boff + n * 2048), *(const LAS bf16x8*)(lds + PG8_SB(b, h) + boff + n * 2048 + 1024)); \
        else { const int bb_ = (int)(uintptr_t)(lds + PG8_SB(b, h) + boff); _Pragma("unroll") for (int k = 0; k < 2; ++k) PG8_ASMRD(dst[n][k], bb_, n * 2048 + k * 1024); } } } while (0)
#define PG8_MMA(ai, bj, At, Bt) do { __builtin_amdgcn_s_setprio(1); _Pragma("unroll") for (int m = 0; m < 4; ++m) _Pragma("unroll") for (int n = 0; n < 2; ++n) { \
        if constexpr (F8) asm volatile("v_mfma_scale_f32_16x16x128_f8f6f4 %0, %1, %2, %0, %3, %3 op_sel_hi:[0,0,0]" : "+v"(acc[ai][bj][m][n]) : "v"(Bt##8[n]), "v"(At##8[m]), "v"(sc8_));     \
        else { _Pragma("unroll") for (int k = 0; k < 2; ++k) acc[ai][bj][m][n] = __builtin_amdgcn_mfma_f32_16x16x32_bf16(Bt[n][k], At[m][k], acc[ai][bj][m][n], 0, 0, 0); } } \
        __builtin_amdgcn_s_setprio(0); } while (0)
#define PG8_WAIT_V(n) asm volatile("s_waitcnt vmcnt(" #n ")" ::: "memory")
#define PG8_WAIT_L(n) asm volatile("s_waitcnt lgkmcnt(" #n ")" ::: "memory")
#define PG8_BAR __builtin_amdgcn_s_barrier()
#define PG8_SCHED __builtin_amdgcn_sched_barrier(0)
    Unit cur, nxt; int ui = 0;
    constexpr bool RELAXABLE = !epi_has_pre<Epi>();
    if (!S.next(0, cur)) return;
    f32x4 acc[2][2][4][2];
#pragma unroll
    for (int a = 0; a < 2; ++a)
#pragma unroll
        for (int b = 0; b < 2; ++b)
#pragma unroll
            for (int m = 0; m < 4; ++m)
#pragma unroll
                for (int n = 0; n < 2; ++n) acc[a][b][m][n] = (f32x4){0.f, 0.f, 0.f, 0.f};
    const int sc8_ = 0x7f7f7f7f;
    bf16x8 At[4][2], B0[2][2], B1[2][2]; v8i32 At8[4], B08[2], B18[2];
    const char* cA = (const char*)g.A + (size_t)cur.pm * tstepA; const char* cB = (const char*)g.Bt + (size_t)cur.pn * tstepB;
    if constexpr (SP2) {
        PG8_STAGE(PG8_SB(0, 0), cB, voffB); PG8_STAGE(PG8_SB(0, 1), cB + hstepB, voffB); PG8_STAGE(PG8_SA(0, 0), cA, voffA); PG8_STAGE(PG8_SA(0, 1), cA + hstepA, voffA);
        if (wr == 1) PG8_BAR;
        PG8_WAIT_V(2); PG8_BAR;
        PG8_STAGE(PG8_SB(1, 0), cB + kstep, voffB); PG8_STAGE(PG8_SA(1, 0), cA + kstep, voffA); PG8_STAGE(PG8_SB(1, 1), cB + hstepB + kstep, voffB);
        PG8_WAIT_V(6); PG8_BAR;
    } else {
        PG8_STAGE(PG8_SB(0, 0), cB, voffB); PG8_STAGE(PG8_SA(0, 0), cA, voffA); PG8_STAGE(PG8_SB(0, 1), cB + hstepB, voffB); PG8_STAGE(PG8_SA(0, 1), cA + hstepA, voffA);
        if (wr == 1) PG8_BAR;
        PG8_WAIT_V(4); PG8_BAR;
        PG8_STAGE(PG8_SB(1, 0), cB + kstep, voffB); PG8_STAGE(PG8_SA(1, 0), cA + kstep, voffA); PG8_STAGE(PG8_SB(1, 1), cB + hstepB + kstep, voffB);
        PG8_WAIT_V(6); PG8_BAR;
    }
    for (;;) {
        const bool has_next = S.next(ui + 1, nxt);
        const char* nA = has_next ? (const char*)g.A + (size_t)nxt.pm * tstepA : cA; const char* nB = has_next ? (const char*)g.Bt + (size_t)nxt.pn * tstepB : cB;
        for (int t = 0; t < nt; t += 2) {
            const bool last = (t == nt - 2);
            const char* a1 = cA + (size_t)(t + 1) * kstep;
            const char* a2 = last ? nA : cA + (size_t)(t + 2) * kstep; const char* b2 = last ? nB : cB + (size_t)(t + 2) * kstep;
            const char* a3 = a2 + kstep; const char* b3 = b2 + kstep;
            if constexpr (Epi::MID) { if (t == Epi::MID_T) E.mid(acc, cur, wr, wc, fr, fq); }
            const int relax = __builtin_amdgcn_readfirstlane((RELAXABLE && t == 0 && ui > 0) ? 1 : 0);
#define PG8_WAIT_V8_UNLESS_RELAX asm volatile("s_cmp_lg_u32 %0, 0\n\ts_cbranch_scc1 .Lpg8relax%=\n\ts_waitcnt vmcnt(8)\n.Lpg8relax%=:" :: "s"(relax) : "scc", "memory")
            if constexpr (SP2) {
            PG8_LDB(B0, 0, 0); PG8_SCHED; PG8_LDA(At, 0, 0); PG8_SCHED; PG8_LDB(B1, 0, 1); PG8_STAGE(PG8_SA(1, 1), a1 + hstepA, voffA);
            if constexpr (RELAXABLE) PG8_WAIT_V8_UNLESS_RELAX; else PG8_WAIT_V(8); if (wr == 1) PG8_WAIT_L(0); else PG8_WAIT_L(4); PG8_BAR; PG8_SCHED; PG8_MMA(0, 0, At, B0); PG8_WAIT_L(0); PG8_SCHED; PG8_MMA(0, 1, At, B1); PG8_BAR; PG8_SCHED;
            PG8_LDA(At, 0, 1); PG8_STAGE(PG8_SB(0, 0), b2, voffB); PG8_STAGE(PG8_SB(0, 1), b2 + hstepB, voffB); PG8_STAGE(PG8_SA(0, 0), a2, voffA);
            if constexpr (RELAXABLE) PG8_WAIT_V8_UNLESS_RELAX; else PG8_WAIT_V(8); PG8_WAIT_L(0); PG8_BAR; PG8_SCHED; PG8_MMA(1, 0, At, B0); PG8_MMA(1, 1, At, B1); PG8_BAR; PG8_SCHED;
            PG8_LDB(B0, 1, 0); PG8_SCHED; PG8_LDA(At, 1, 0); PG8_SCHED; PG8_LDB(B1, 1, 1); PG8_STAGE(PG8_SA(0, 1), a2 + hstepA, voffA);
            PG8_WAIT_V(8); if (wr == 1) PG8_WAIT_L(0); else PG8_WAIT_L(4); PG8_BAR; PG8_SCHED; PG8_MMA(0, 0, At, B0); PG8_WAIT_L(0); PG8_SCHED; PG8_MMA(0, 1, At, B1); PG8_BAR; PG8_SCHED;
            PG8_LDA(At, 1, 1); PG8_STAGE(PG8_SB(1, 0), b3, voffB); PG8_STAGE(PG8_SB(1, 1), b3 + hstepB, voffB); PG8_STAGE(PG8_SA(1, 0), a3, voffA);
            PG8_WAIT_V(8); PG8_WAIT_L(0); PG8_BAR; PG8_SCHED; PG8_MMA(1, 0, At, B0); PG8_MMA(1, 1, At, B1); PG8_BAR; PG8_SCHED;
            } else {
            PG8_LDB(B0, 0, 0); PG8_SCHED; PG8_LDA(At, 0, 0); PG8_STAGE(PG8_SA(1, 1), a1 + hstepA, voffA);
            PG8_WAIT_L(8); PG8_BAR; PG8_WAIT_L(0); PG8_MMA(0, 0, At, B0); PG8_BAR; PG8_SCHED;
            PG8_LDB(B1, 0, 1); PG8_STAGE(PG8_SB(0, 0), b2, voffB);
            PG8_BAR; PG8_WAIT_L(0); PG8_MMA(0, 1, At, B1); PG8_BAR;
            PG8_LDA(At, 0, 1); PG8_STAGE(PG8_SA(0, 0), a2, voffA);
            PG8_BAR; PG8_WAIT_L(0); PG8_MMA(1, 0, At, B0); PG8_BAR; PG8_SCHED;
            PG8_STAGE(PG8_SB(0, 1), b2 + hstepB, voffB);
            PG8_WAIT_V(6); PG8_BAR; PG8_MMA(1, 1, At, B1); PG8_BAR;
            PG8_LDB(B0, 1, 0); PG8_SCHED; PG8_LDA(At, 1, 0); PG8_STAGE(PG8_SA(0, 1), a2 + hstepA, voffA);
            PG8_WAIT_L(8); PG8_BAR; PG8_WAIT_L(0); PG8_MMA(0, 0, At, B0); PG8_BAR; PG8_SCHED;
            PG8_LDB(B1, 1, 1); PG8_STAGE(PG8_SB(1, 0), b3, voffB);
            PG8_BAR; PG8_WAIT_L(0); PG8_MMA(0, 1, At, B1); PG8_BAR;
            PG8_LDA(At, 1, 1); PG8_STAGE(PG8_SA(1, 0), a3, voffA);
            PG8_BAR; PG8_WAIT_L(0); PG8_MMA(1, 0, At, B0); PG8_BAR; PG8_SCHED;
            PG8_STAGE(PG8_SB(1, 1), b3 + hstepB, voffB);
            PG8_WAIT_V(6); PG8_BAR; PG8_MMA(1, 1, At, B1); PG8_BAR;
            }
        }
        if constexpr (SP2 && RELAXABLE) PG8_WAIT_V(0);
        f32x4 pre_ = {0.f, 0.f, 0.f, 0.f};
        if constexpr (Epi::TILE) { if constexpr (Epi::PRE) { pre_ = E.pre(cur, wr, wc, fr, fq); PG8_SCHED; } }
        if constexpr (ALIGN_EPI) { if (wr == 0) PG8_BAR; }
        if constexpr (F8) asm volatile("s_nop 15\n\ts_nop 7" ::: "memory");
        if constexpr (Epi::TILE) { if constexpr (Epi::PRE) E.tile(acc, cur, wr, wc, fr, fq, lds + HALO_OFF, pre_); else E.tile(acc, cur, wr, wc, fr, fq, lds + HALO_OFF); } else run_epi(E, acc, cur, wr, wc, fr, fq);
        if (!has_next) break;
#pragma unroll
        for (int a = 0; a < 2; ++a)
#pragma unroll
            for (int b = 0; b < 2; ++b)
#pragma unroll
                for (int m = 0; m < 4; ++m)
#pragma unroll
                    for (int n = 0; n < 2; ++n) acc[a][b][m][n] = (f32x4){0.f, 0.f, 0.f, 0.f};
        cur = nxt; cA = nA; cB = nB; ++ui;
        if constexpr (ALIGN_EPI) { if (wr == 1) PG8_BAR; }
    }
    PG8_WAIT_V(0);
    if constexpr (!ALIGN_EPI) { if (wr == 0) PG8_BAR; }
    PG8_BAR;
#undef PG8_SA
#undef PG8_SB
#undef PG8_STAGE
#undef PG8_ASMRD
#undef PG8_LDA
#undef PG8_LDB
#undef PG8_MMA
#undef PG8_WAIT_V
#undef PG8_WAIT_V8_UNLESS_RELAX
#undef PG8_WAIT_L
#undef PG8_BAR
#undef PG8_SCHED
}
}

__device__ __forceinline__ float gelu_tanh(float x) {
    constexpr float K0 = -2.0f * LOG2E * 0.7978845608028654f, K1 = K0 * 0.044715f;
    return x * __builtin_amdgcn_rcpf(1.0f + fast_exp2(x * __builtin_fmaf(x * x, K1, K0))); }

template <int SH> __device__ __forceinline__ float dpp_prev(float cur, float pg) {
    const int o = __builtin_amdgcn_mov_dpp(__float_as_int(pg), 0x120 + SH, 0xf, 0xf, true);
    return __int_as_float(__builtin_amdgcn_update_dpp(o, __float_as_int(cur), 0x110 + SH, 0xf, 0xf, false));
}
struct EpiConv {
    static constexpr bool TILE = true, MID = false, PRE = true;
    const float* cw; const float* cb; bf16_t* ACT; float* UH; float* UF;
    __device__ __forceinline__ f32x4 pre(const pg8::Unit& u, int wr, int wc, int fr, int fq) const {
        f32x4 r = {0.f, 0.f, 0.f, 0.f}; const int cwt = wc * 64 + fq * 16 + fr, cwrow = cwt >> 5, cwc = (cwt & 31) * 4;
        if (wr == 0) { const int rr = cwrow & 3; r = *(const f32x4*)((rr < 3 ? cw + (size_t)rr * N_UP : cb) + (cwrow >> 2) * DFF + u.pn * 128 + cwc); }
        return r; }
    __device__ __forceinline__ void tile(const f32x4 (&acc)[2][2][4][2], const pg8::Unit& u, int wr, int wc, int fr, int fq, LAS unsigned char* halo_b, f32x4 cwreg) const {
        LAS float* halo = (LAS float*)halo_b;
        LAS float* cwl = (LAS float*)(halo_b + 8192);
        const int chl = wc * 32 + fq * 8, ch0 = u.pn * 128 + chl;
        const int cwt = wc * 64 + fq * 16 + fr, cwrow = cwt >> 5, cwc = (cwt & 31) * 4;
#pragma unroll
        for (int ai = 0; ai < 2; ++ai) {
            if (fr >= 14) { LAS float* hp = halo + ((2 * ai + wr) * 2 + (fr - 14)) * 256 + chl;
#pragma unroll
                for (int bj = 0; bj < 2; ++bj) { *(LAS f32x4*)(hp + bj * 128) = acc[ai][bj][3][0]; *(LAS f32x4*)(hp + bj * 128 + 4) = acc[ai][bj][3][1]; } }
        }
        if (wr == 0) *(LAS f32x4*)(cwl + cwrow * 128 + cwc) = cwreg;
        if (wr == 1 && fr >= 14) { float* gp = UH + ((size_t)u.pm * 2 + (fr - 14)) * N_UP + u.pn * 256 + chl;
#pragma unroll
            for (int bj = 0; bj < 2; ++bj) { *(f32x4*)(gp + bj * 128) = acc[1][bj][3][0]; *(f32x4*)(gp + bj * 128 + 4) = acc[1][bj][3][1]; } }
        if (wr == 0 && fr < 2) { float* gp = UF + ((size_t)u.pm * 2 + fr) * N_UP + u.pn * 256 + chl;
#pragma unroll
            for (int bj = 0; bj < 2; ++bj) { *(f32x4*)(gp + bj * 128) = acc[0][bj][0][0]; *(f32x4*)(gp + bj * 128 + 4) = acc[0][bj][0][1]; } }
        asm volatile("s_waitcnt lgkmcnt(0)" ::: "memory"); __builtin_amdgcn_s_barrier(); asm volatile("" ::: "memory");
#pragma unroll
        for (int ai = 0; ai < 2; ++ai) {
            const int q = 2 * ai + wr;
            unsigned outw[4][4];
#pragma unroll
            for (int ep = 0; ep < 4; ++ep) {
                const int n = ep >> 1, i0 = (ep & 1) * 2;
                const LAS float* wp = cwl + chl + 2 * ep;
                const f32x2 wg0 = *(const LAS f32x2*)wp, wg1 = *(const LAS f32x2*)(wp + 128), wg2 = *(const LAS f32x2*)(wp + 256), bg = *(const LAS f32x2*)(wp + 384);
                const f32x2 wv0 = *(const LAS f32x2*)(wp + 512), wv1 = *(const LAS f32x2*)(wp + 640), wv2 = *(const LAS f32x2*)(wp + 768), bv = *(const LAS f32x2*)(wp + 896);
                float pga = 0.f, pgb = 0.f, pva = 0.f, pvb = 0.f;
                if (q > 0 && fr >= 14) { const LAS float* hp = halo + ((q - 1) * 2 + (fr - 14)) * 256 + chl + 2 * ep;
                    const f32x2 hg = *(const LAS f32x2*)hp, hv = *(const LAS f32x2*)(hp + 128); pga = hg[0]; pgb = hg[1]; pva = hv[0]; pvb = hv[1]; }
#pragma unroll
                for (int m = 0; m < 4; ++m) {
                    const float ga = acc[ai][0][m][n][i0], gb = acc[ai][0][m][n][i0 + 1], va = acc[ai][1][m][n][i0], vb = acc[ai][1][m][n][i0 + 1];
                    const f32x2 g0 = {ga, gb}, g1 = {dpp_prev<1>(ga, pga), dpp_prev<1>(gb, pgb)}, g2 = {dpp_prev<2>(ga, pga), dpp_prev<2>(gb, pgb)};
                    const f32x2 v0 = {va, vb}, v1 = {dpp_prev<1>(va, pva), dpp_prev<1>(vb, pvb)}, v2 = {dpp_prev<2>(va, pva), dpp_prev<2>(vb, pvb)};
                    const f32x2 u = __builtin_elementwise_fma(wg2, g0, __builtin_elementwise_fma(wg1, g1, __builtin_elementwise_fma(wg0, g2, bg)));
                    const f32x2 x = __builtin_elementwise_fma(wv2, v0, __builtin_elementwise_fma(wv1, v1, __builtin_elementwise_fma(wv0, v2, bv)));
                    constexpr float K0 = -2.0f * LOG2E * 0.7978845608028654f, K1 = K0 * 0.044715f;
                    const f32x2 ez = u * (u * u * K1 + K0);
                    const f32x2 den = (f32x2){fast_exp2(ez[0]), fast_exp2(ez[1])} + 1.0f;
                    const f32x2 y = u * x * (f32x2){__builtin_amdgcn_rcpf(den[0]), __builtin_amdgcn_rcpf(den[1])};
                    outw[m][ep] = cvt_pk_bf16(y[0], y[1]);
                    pga = ga; pgb = gb; pva = va; pvb = vb;
                }
            }
#pragma unroll
            for (int m = 0; m < 4; ++m) { u32x4 w; w.x = outw[m][0]; w.y = outw[m][1]; w.z = outw[m][2]; w.w = outw[m][3];
                *(u32x4*)(ACT + (size_t)(u.pm * 256 + ai * 128 + wr * 64 + m * 16 + fr) * DFF + ch0) = w; }
            asm volatile("" ::: "memory");
        }
    }
};
__device__ __forceinline__ void fixup_item(const float* UH, const float* UF, const float* cw, const float* cb, bf16_t* ACT, int pm, int rr, int chunk) {
    {
        const int c0 = chunk * 8, colg = (c0 >> 7) * 256 + (c0 & 127);
        float o[8];
#pragma unroll
        for (int h = 0; h < 2; ++h) {
            const f32x4 gm2 = *(const f32x4*)(UH + ((size_t)(pm - 1) * 2 + 0) * N_UP + colg + 4 * h), gm1 = *(const f32x4*)(UH + ((size_t)(pm - 1) * 2 + 1) * N_UP + colg + 4 * h);
            const f32x4 g0 = *(const f32x4*)(UF + ((size_t)pm * 2 + 0) * N_UP + colg + 4 * h), g1 = *(const f32x4*)(UF + ((size_t)pm * 2 + 1) * N_UP + colg + 4 * h);
            const f32x4 vm2 = *(const f32x4*)(UH + ((size_t)(pm - 1) * 2 + 0) * N_UP + colg + 128 + 4 * h), vm1 = *(const f32x4*)(UH + ((size_t)(pm - 1) * 2 + 1) * N_UP + colg + 128 + 4 * h);
            const f32x4 v0 = *(const f32x4*)(UF + ((size_t)pm * 2 + 0) * N_UP + colg + 128 + 4 * h), v1 = *(const f32x4*)(UF + ((size_t)pm * 2 + 1) * N_UP + colg + 128 + 4 * h);
#pragma unroll
            for (int e = 0; e < 4; ++e) { const int c = c0 + 4 * h + e;
                const float a2 = rr ? gm1[e] : gm2[e], a1 = rr ? g0[e] : gm1[e], a0 = rr ? g1[e] : g0[e];
                const float b2 = rr ? vm1[e] : vm2[e], b1 = rr ? v0[e] : vm1[e], b0 = rr ? v1[e] : v0[e];
                const float ug = cw[c] * a2 + cw[N_UP + c] * a1 + cw[2 * N_UP + c] * a0 + cb[c];
                const float uv = cw[DFF + c] * b2 + cw[N_UP + DFF + c] * b1 + cw[2 * N_UP + DFF + c] * b0 + cb[DFF + c];
                o[4 * h + e] = gelu_tanh(ug) * uv; }
        }
        store_bf16x8(ACT + (size_t)(pm * 256 + rr) * DFF + c0, o);
    }
}
__device__ __forceinline__ void fixup_phase(const float* UH, const float* UF, const float* cw, const float* cb, bf16_t* ACT, int wv) {
    const int gt = (int)blockIdx.x * (NWAVES * 64) + opaque_tid(wv), NT = (int)gridDim.x * NWAVES * 64;
    constexpr int NCH = DFF / 8;
    for (int it = gt; it < 56 * 2 * NCH; it += NT) {
        const int chunk = it % NCH, rr = (it / NCH) & 1, k = it / (2 * NCH), pm = (k / 7) * 8 + (k % 7) + 1;
        fixup_item(UH, UF, cw, cb, ACT, pm, rr, chunk);
    }
}
__device__ __forceinline__ void fixup_local(const float* UH, const float* UF, const float* cw, const float* cb, bf16_t* ACT, int wv, int cid) {
    pg8::StaticOrder S; S.init(M, DM, (int)gridDim.x, cid);
    const int tid = opaque_tid(wv); constexpr int NCH = DFF / 8;
    pg8::Unit u; int prev = -1;
    for (int i = 0; S.next(i, u); ++i) {
        if (u.pm == prev || (u.pm & 7) == 0) continue;
        prev = u.pm;
#pragma unroll
        for (int j = 0; j < 3; ++j) { const int it = tid + j * (NWAVES * 64), itc = it < 2 * NCH ? it : 2 * NCH - 1; fixup_item(UH, UF, cw, cb, ACT, u.pm, itc / NCH, itc % NCH); }
    }
    asm volatile("s_waitcnt vmcnt(0)" ::: "memory");
    __syncthreads();
}

__device__ __forceinline__ void flogit_phase(LAS unsigned char* lds, const bf16_t* Hm, const bf16_t* WfT, const EpiInProj& E, int wv, int cid) {
    const int tid = opaque_tid(wv), wave = __builtin_amdgcn_readfirstlane(tid >> 6), lane = tid & 63, fr = lane & 15, fq = lane >> 4;
    const int rb = wave & 3, kh = wave >> 2;
    LAS float* xch = (LAS float*)(lds + HALO_OFF) + (rb * 16 + fr) * 8;
    for (int blk0 = (cid & 7) * (SEQ / 16) + (cid >> 3) * 4; blk0 < ((cid & 7) + 1) * (SEQ / 16); blk0 += ((int)gridDim.x >> 3) * 4) {
        const int blk = blk0 + rb;
        f32x4 a0 = {0.f, 0.f, 0.f, 0.f}, a1 = a0;
        const bf16_t* ap = Hm + (size_t)(blk * 16 + fr) * DM + fq * 8 + kh * (DM / 2);
        const bf16_t* bp0 = WfT + (size_t)perm32(fr) * DM + fq * 8 + kh * (DM / 2);
        const bf16_t* bp1 = WfT + (size_t)perm32(16 + fr) * DM + fq * 8 + kh * (DM / 2);
#pragma unroll 8
        for (int k0 = 0; k0 < DM / 2; k0 += 32) {
            const bf16x8 af = *(const bf16x8*)(ap + k0), b0 = *(const bf16x8*)(bp0 + k0), b1 = *(const bf16x8*)(bp1 + k0);
            a0 = __builtin_amdgcn_mfma_f32_16x16x32_bf16(b0, af, a0, 0, 0, 0); a1 = __builtin_amdgcn_mfma_f32_16x16x32_bf16(b1, af, a1, 0, 0, 0);
        }
        if (kh == 1 && fq == 0) { *(LAS f32x4*)xch = a0; *(LAS f32x4*)(xch + 4) = a1; }
        __syncthreads();
        if (kh == 0 && fq == 0) { const f32x4 c0 = *(const LAS f32x4*)xch, c1 = *(const LAS f32x4*)(xch + 4);
            const float v[8] = {a0[0] + c0[0], a0[1] + c0[1], a0[2] + c0[2], a0[3] + c0[3], a1[0] + c1[0], a1[1] + c1[1], a1[2] + c1[2], a1[3] + c1[3]}; E(blk * 16 + fr, N_QKV, v, 30); }
        __syncthreads();
    }
}
template <bool F8 = false, class Epi>
__device__ __forceinline__ void run_gemm(LAS unsigned char* lds, const Gemm g, const Epi& E, int wv, int cid, int split = 0) {
#if FAST_GEMM
    pg8::StaticOrder S; S.init(g.M, g.N, (int)gridDim.x, cid); S.split = (split && S.nwg == 4 * (int)gridDim.x) ? 1 : 0;
    pg8::gemm_phase<Epi, GEMM_ALIGN, GEMM_SP2, F8>(lds, g, S, E, wv);
#else
    static_assert(!Epi::TILE && !Epi::MID && !F8, "tile / mid-loop epilogues and fp8 operands need the fast body");
    const int tid = opaque_tid(wv), wave = __builtin_amdgcn_readfirstlane(tid >> 6);
    gemm_naive(g, E, (int)blockIdx.x * NWAVES + wave, (int)gridDim.x * NWAVES, tid & 63);
#endif
}

__device__ __forceinline__ unsigned pk4_fp8(float a, float b, float c, float d) {
    a = fminf(fmaxf(a, -440.f), 440.f); b = fminf(fmaxf(b, -440.f), 440.f); c = fminf(fmaxf(c, -440.f), 440.f); d = fminf(fmaxf(d, -440.f), 440.f);
    int w = 0; w = __builtin_amdgcn_cvt_pk_fp8_f32(a, b, w, false); w = __builtin_amdgcn_cvt_pk_fp8_f32(c, d, w, true); return (unsigned)w;
}
__device__ __forceinline__ void transpose_item_f8(const float* W, int ldw, int c0, int K, int ncols, unsigned char* WT8, float scale, LAS float* scr, int item, int lane) {
    const int nblk = ncols / 32, kb = item / nblk, nb = item % nblk, k0 = 64 * kb, n0 = 32 * nb;
    const int gc = n0 < DM ? n0 : n0 - DM, ro = 256 * (gc >> 7) + (n0 < DM ? 0 : 128) + (gc & 127) - n0;
#pragma unroll
    for (int i = 0; i < 8; ++i) { const int kk = 8 * i + (lane >> 3);
        const f32x4 v = *(const f32x4*)(W + (size_t)(k0 + kk) * ldw + c0 + n0 + (lane & 7) * 4); LAS float* d = scr + kk * 33 + (lane & 7) * 4;
        d[0] = v[0] * scale; d[1] = v[1] * scale; d[2] = v[2] * scale; d[3] = v[3] * scale; }
    asm volatile("s_waitcnt lgkmcnt(0)" ::: "memory");
    const int c = lane & 7;
#pragma unroll
    for (int j = 0; j < 4; ++j) { const int n = (lane >> 3) + 8 * j; const LAS float* s = scr + (8 * c) * 33 + n;
        u32x2 o; o.x = pk4_fp8(s[0 * 33], s[1 * 33], s[2 * 33], s[3 * 33]); o.y = pk4_fp8(s[4 * 33], s[5 * 33], s[6 * 33], s[7 * 33]);
        *(u32x2*)(WT8 + (size_t)(ro + n0 + n) * K + k0 + 8 * c) = o; }
    asm volatile("s_waitcnt lgkmcnt(0)" ::: "memory");
}
template <bool UPPERM = false>
__device__ __forceinline__ void transpose_item(const float* W, int ldw, int c0, int K, int ncols, bf16_t* WT, int row_off, LAS float* scr, int item, int lane, int ldk = 0, int koff = 0) {
    if (ldk == 0) ldk = K;
    const int nblk = ncols / 32, kb = item / nblk, nb = item % nblk, k0 = 64 * kb, n0 = 32 * nb;
    if (UPPERM) { const int c = n0 < DFF ? n0 : n0 - DFF; row_off = 256 * (c >> 7) + (n0 < DFF ? 0 : 128) + (c & 127) - n0; }
#pragma unroll
    for (int i = 0; i < 8; ++i) { const int kk = 8 * i + (lane >> 3);
        const f32x4 v = *(const f32x4*)(W + (size_t)(k0 + kk) * ldw + c0 + n0 + (lane & 7) * 4); LAS float* d = scr + kk * 33 + (lane & 7) * 4;
        d[0] = v[0]; d[1] = v[1]; d[2] = v[2]; d[3] = v[3]; }
    asm volatile("s_waitcnt lgkmcnt(0)" ::: "memory");
    const int c = lane & 7;
#pragma unroll
    for (int j = 0; j < 4; ++j) { const int n = (lane >> 3) + 8 * j; const LAS float* s = scr + (8 * c) * 33 + n;
        u32x4 o; o.x = cvt_pk_bf16(s[0 * 33], s[1 * 33]); o.y = cvt_pk_bf16(s[2 * 33], s[3 * 33]); o.z = cvt_pk_bf16(s[4 * 33], s[5 * 33]); o.w = cvt_pk_bf16(s[6 * 33], s[7 * 33]);
        *(u32x4*)(WT + (size_t)(row_off + n0 + n) * ldk + koff + k0 + 8 * c) = o; }
    asm volatile("s_waitcnt lgkmcnt(0)" ::: "memory");
}
__device__ __forceinline__ void rms_row_to_bf16(const float* xrow, const f32x4 (&gv)[8], bf16_t* orow, bf16_t* xcopy, int lane, unsigned char* o8) {
    f32x4 v[8]; float s = 0.f;
#pragma unroll
    for (int j = 0; j < 8; ++j) { v[j] = *((const f32x4*)xrow + 2 * (lane + 64 * (j >> 1)) + (j & 1)); s += (v[j][0] * v[j][0] + v[j][1] * v[j][1]) + (v[j][2] * v[j][2] + v[j][3] * v[j][3]); }
    const float r = 1.0f / sqrtf(wave_sum(s) * (1.0f / DM) + EPS);
#pragma unroll
    for (int c = 0; c < 4; ++c) {
        if (xcopy) { u32x4 w; w.x = cvt_pk_bf16(v[2 * c][0], v[2 * c][1]); w.y = cvt_pk_bf16(v[2 * c][2], v[2 * c][3]); w.z = cvt_pk_bf16(v[2 * c + 1][0], v[2 * c + 1][1]); w.w = cvt_pk_bf16(v[2 * c + 1][2], v[2 * c + 1][3]);
            *((u32x4*)xcopy + lane + 64 * c) = w; }
        const f32x4 a = v[2 * c] * r * gv[2 * c], b = v[2 * c + 1] * r * gv[2 * c + 1];
        u32x4 w; w.x = cvt_pk_bf16(a[0], a[1]); w.y = cvt_pk_bf16(a[2], a[3]); w.z = cvt_pk_bf16(b[0], b[1]); w.w = cvt_pk_bf16(b[2], b[3]);
        *((u32x4*)orow + lane + 64 * c) = w;
        u32x2 q; q.x = pk4_fp8(a[0] * H8_SCALE, a[1] * H8_SCALE, a[2] * H8_SCALE, a[3] * H8_SCALE); q.y = pk4_fp8(b[0] * H8_SCALE, b[1] * H8_SCALE, b[2] * H8_SCALE, b[3] * H8_SCALE);
        *((u32x2*)o8 + lane + 64 * c) = q;
    }
}

struct Ptrs {
    const float *x, *rel_bias, *w_in, *b_f, *w_pa, *w_pb, *w_o, *w_up, *conv_w, *conv_b, *w_down, *g_mix_pre, *g_mix_post, *g_ffn_pre, *g_ffn_post;
    float* out; unsigned char* ws;
};

struct TrItem { const float* src; unsigned char* dst; int ldw, ldkb; float scale; int f8; };
__device__ __forceinline__ TrItem tr_make(const float* W, int ldw, int c0, int K, int ncols, void* WT, int row_off, int item, int ldk, int koff, bool upperm, bool f8, float scale) {
    if (ldk == 0) ldk = K;
    const int nblk = ncols / 32, kb = item / nblk, nb = item % nblk, k0 = 64 * kb, n0 = 32 * nb;
    if (upperm) { const int c = n0 < DFF ? n0 : n0 - DFF; row_off = 256 * (c >> 7) + (n0 < DFF ? 0 : 128) + (c & 127) - n0; }
    if (f8) { const int c = n0 < DM ? n0 : n0 - DM; row_off = 256 * (c >> 7) + (n0 < DM ? 0 : 128) + (c & 127) - n0; }
    TrItem t; t.src = W + (size_t)k0 * ldw + c0 + n0; t.ldw = ldw; t.scale = scale; t.f8 = f8 ? 1 : 0; const int esz = f8 ? 1 : 2;
    t.dst = (unsigned char*)WT + ((size_t)(row_off + n0) * ldk + koff + k0) * esz; t.ldkb = ldk * esz; return t;
}
__device__ __forceinline__ void tr_load(const TrItem& t, f32x4 (&v)[8], int lane) {
#pragma unroll
    for (int i = 0; i < 8; ++i) v[i] = *(const f32x4*)(t.src + (size_t)(8 * i + (lane >> 3)) * t.ldw + (lane & 7) * 4);
}
__device__ __forceinline__ void tr_finish(const TrItem& t, const f32x4 (&v)[8], LAS float* scr, int lane) {
#pragma unroll
    for (int i = 0; i < 8; ++i) { LAS float* d = scr + (8 * i + (lane >> 3)) * 33 + (lane & 7) * 4; d[0] = v[i][0] * t.scale; d[1] = v[i][1] * t.scale; d[2] = v[i][2] * t.scale; d[3] = v[i][3] * t.scale; }
    asm volatile("s_waitcnt lgkmcnt(0)" ::: "memory");
    const int c = lane & 7;
#pragma unroll
    for (int j = 0; j < 4; ++j) { const int n = (lane >> 3) + 8 * j; const LAS float* sp = scr + (8 * c) * 33 + n;
        const float e0 = sp[0 * 33], e1 = sp[1 * 33], e2 = sp[2 * 33], e3 = sp[3 * 33], e4 = sp[4 * 33], e5 = sp[5 * 33], e6 = sp[6 * 33], e7 = sp[7 * 33];
        if (t.f8) { u32x2 o; o.x = pk4_fp8(e0, e1, e2, e3); o.y = pk4_fp8(e4, e5, e6, e7); *(u32x2*)(t.dst + (size_t)n * t.ldkb + 8 * c) = o; }
        else { u32x4 o; o.x = cvt_pk_bf16(e0, e1); o.y = cvt_pk_bf16(e2, e3); o.z = cvt_pk_bf16(e4, e5); o.w = cvt_pk_bf16(e6, e7); *(u32x4*)(t.dst + (size_t)n * t.ldkb + 16 * c) = o; } }
    asm volatile("s_waitcnt lgkmcnt(0)" ::: "memory");
}
namespace cv {
constexpr int I_IN1 = (DM / 64) * (N_QKV / 32), I_IN2 = (DM / 64) * (N_G / 32), I_PA = (512 / 64) * (DM / 32), I_PB = (1024 / 64) * (DM / 32), I_O = (DM / 64) * (DM / 32),
              I_UP = (DM / 64) * (N_UP / 32), I_DN = (DFF / 64) * (DM / 32);
constexpr int PER_LAYER = I_IN1 + I_IN2 + I_PA + I_PB + I_O + I_UP + I_DN;
static_assert(PER_LAYER % 8 == 0, "a layer's transpose items split evenly over the eight groups");
}
__device__ __forceinline__ void convert_range(const Ptrs& P, LAS float* scr, int layer, int r_begin, int r_end, int first, int stride, int lane) {
    using namespace cv;
    unsigned char* ws = P.ws;
    bf16_t* win = (bf16_t*)(ws + WS_WIN + layer * SZ_WIN);
    const float* w_in = P.w_in + (size_t)layer * DM * N_IN;
    for (int it = r_begin + first; it < r_end; it += stride) {
        int r = it;
        if (r < I_IN1) { transpose_item(w_in, N_IN, 0, DM, N_QKV, win, 0, scr, r, lane); continue; } r -= I_IN1;
        if (r < I_IN2) { transpose_item_f8(w_in, N_IN, N_QKV + 8, DM, N_G, (unsigned char*)win + OFF_WG8, W8_SCALE, scr, r, lane); continue; } r -= I_IN2;
        if (r < I_PA) { transpose_item(P.w_pa + (size_t)layer * 512 * DM, DM, 0, 512, DM, (bf16_t*)(ws + WS_WPA + layer * SZ_WPAB), 0, scr, r, lane, YAB_W, 0); continue; } r -= I_PA;
        if (r < I_PB) { transpose_item(P.w_pb + (size_t)layer * 1024 * DM, DM, 0, 1024, DM, (bf16_t*)(ws + WS_WPA + layer * SZ_WPAB), 0, scr, r, lane, YAB_W, 512); continue; } r -= I_PB;
        if (r < I_O) { transpose_item(P.w_o + (size_t)layer * DM * DM, DM, 0, DM, DM, (bf16_t*)(ws + WS_WO + layer * SZ_WO), 0, scr, r, lane); continue; } r -= I_O;
        if (r < I_UP) { transpose_item<true>(P.w_up + (size_t)layer * DM * N_UP, N_UP, 0, DM, N_UP, (bf16_t*)(ws + WS_WUP + layer * SZ_WUP), 0, scr, r, lane); continue; } r -= I_UP;
        transpose_item(P.w_down + (size_t)layer * DFF * DM, DM, 0, DFF, DM, (bf16_t*)(ws + WS_WDN + layer * SZ_WDN), 0, scr, r, lane);
    }
}
__device__ __forceinline__ void convert_range_pipe(const Ptrs& P, LAS float* scr, int layer, int r_begin, int r_end, int first, int stride, int lane) {
    using namespace cv;
    unsigned char* ws = P.ws;
    auto decode = [&](int it) -> TrItem {
        int r = it;
        bf16_t* win = (bf16_t*)(ws + WS_WIN + layer * SZ_WIN);
        const float* w_in = P.w_in + (size_t)layer * DM * N_IN;
        if (r < I_IN1) return tr_make(w_in, N_IN, 0, DM, N_QKV, win, 0, r, 0, 0, false, false, 1.0f); r -= I_IN1;
        if (r < I_IN2) return tr_make(w_in, N_IN, N_QKV + 8, DM, N_G, (unsigned char*)win + OFF_WG8, 0, r, 0, 0, false, true, W8_SCALE); r -= I_IN2;
        if (r < I_PA) return tr_make(P.w_pa + (size_t)layer * 512 * DM, DM, 0, 512, DM, ws + WS_WPA + layer * SZ_WPAB, 0, r, YAB_W, 0, false, false, 1.0f); r -= I_PA;
        if (r < I_PB) return tr_make(P.w_pb + (size_t)layer * 1024 * DM, DM, 0, 1024, DM, ws + WS_WPA + layer * SZ_WPAB, 0, r, YAB_W, 512, false, false, 1.0f); r -= I_PB;
        if (r < I_O) return tr_make(P.w_o + (size_t)layer * DM * DM, DM, 0, DM, DM, ws + WS_WO + layer * SZ_WO, 0, r, 0, 0, false, false, 1.0f); r -= I_O;
        if (r < I_UP) return tr_make(P.w_up + (size_t)layer * DM * N_UP, N_UP, 0, DM, N_UP, ws + WS_WUP + layer * SZ_WUP, 0, r, 0, 0, true, false, 1.0f); r -= I_UP;
        return tr_make(P.w_down + (size_t)layer * DFF * DM, DM, 0, DFF, DM, ws + WS_WDN + layer * SZ_WDN, 0, r, 0, 0, false, false, 1.0f);
    };
    f32x4 va[8], vb[8]; TrItem ta, tb;
    int it = r_begin + first;
    if (it < r_end) { ta = decode(it); tr_load(ta, va, lane); }
    for (; it < r_end; it += 2 * stride) {
        const bool hb = it + stride < r_end;
        if (hb) { tb = decode(it + stride); tr_load(tb, vb, lane); }
        tr_finish(ta, va, scr, lane);
        if (!hb) break;
        if (it + 2 * stride < r_end) { ta = decode(it + 2 * stride); tr_load(ta, va, lane); }
        tr_finish(tb, vb, scr, lane);
    }
}
__device__ __forceinline__ void convert_share(const Ptrs& P, LAS unsigned char* lds, int layer, int wv, int cid, int lo = 0, int hi = cv::PER_LAYER, int rank0 = 0) {
    const int tid = opaque_tid(wv), wave = __builtin_amdgcn_readfirstlane(tid >> 6), lane = tid & 63;
    LAS float* scr = (LAS float*)(lds + wave * 16384);
    const int g = cid & 7, per = (hi - lo) / 8, rk = (cid >> 3) - rank0;
    if (rk < 0 || rk >= CV_WGS) return;
    convert_range_pipe(P, scr, layer, lo + g * per, lo + (g + 1) * per, rk * NWAVES + wave, CV_WGS * NWAVES, lane);
    asm volatile("s_waitcnt vmcnt(0)" ::: "memory"); __syncthreads();
}
__device__ __forceinline__ void p0_prologue(const Ptrs& P, LAS unsigned char* lds, int wv) {
    const int tid = opaque_tid(wv), wave = __builtin_amdgcn_readfirstlane(tid >> 6), lane = tid & 63;
    LAS float* scr = (LAS float*)(lds + wave * 16384);
    const int gw = (int)blockIdx.x * NWAVES + wave, NGW = (int)gridDim.x * NWAVES;
    unsigned char* ws = P.ws;
    for (int layer = 0; layer < (LATE_CONVERT ? 1 : DEPTH); ++layer) convert_range(P, scr, layer, 0, (LATE_CONVERT && LATE0) ? cv::I_IN1 + cv::I_IN2 : cv::PER_LAYER, gw, NGW, lane);
    {
        const int gt = (int)blockIdx.x * (NWAVES * 64) + tid, NT = (int)gridDim.x * NWAVES * 64;
        for (int i = gt; i < DEPTH * 256 * DM; i += NT) {
            const int layer = i / (256 * DM), rr = (i / DM) % 256, k = i % DM;
            const float v = rr < 8 ? P.w_in[(size_t)layer * DM * N_IN + (size_t)k * N_IN + N_QKV + rr] : 0.f;
            ((bf16_t*)(ws + WS_WIN + layer * SZ_WIN))[(size_t)(N_QKV + rr) * DM + k] = (bf16_t)(cvt_pk_bf16(v, 0.f) & 0xffffu);
        }
        float* tab = (float*)(ws + WS_TAB);
        for (int i = gt; i < 12 * 132; i += NT) {
            const int head = i / 132, d = i % 132, g = head >> 2, dil = g == 0 ? 1 : (g == 1 ? 4 : 16);
            tab[i] = P.rel_bias[t5_bucket(d * dil) * 12 + head] * LOG2E;
        }
    }
    {
        f32x4 gv[8];
#pragma unroll
        for (int j = 0; j < 8; ++j) gv[j] = *((const f32x4*)P.g_mix_pre + 2 * (lane + 64 * (j >> 1)) + (j & 1));
        bf16_t* H = (bf16_t*)(ws + WS_H); bf16_t* XBr = (bf16_t*)(ws + WS_XB);
        for (int m = gw; m < M; m += NGW) rms_row_to_bf16(P.x + (size_t)m * DM, gv, H + (size_t)m * DM, (bf16_t*)(ws + WS_XB) + (size_t)m * DM, lane, ws + WS_H8 + (size_t)m * DM);
    }
}

__device__ __forceinline__ void attn_naive(const bf16_t* QKV, const float* LOGF, const float* TAB, bf16_t* YAB, int wv) {
    const int tid = opaque_tid(wv), lane = tid & 63, gw = (int)blockIdx.x * NWAVES + __builtin_amdgcn_readfirstlane(tid >> 6), ngw = (int)gridDim.x * NWAVES;
    for (int i = gw, k = 0; i < BATCH * 8 * SEQ; i += ngw, ++k) {
        const int bh = i >> 11; int t = i & 2047; if (k & 1) t = 2047 - t;
        const int b = bh >> 3, h = bh & 7;
        const unsigned qw = *(const unsigned*)(QKV + (size_t)(b * SEQ + t) * N_QKV + N_A + h * HD + 2 * lane);
        const float q0 = bf_lo(qw), q1 = bf_hi(qw);
        float m = -1e30f, l = 0.f, o0 = 0.f, o1 = 0.f, c = 0.f;
        for (int s = 0; s <= t; ++s) {
            const bf16_t* kp = QKV + (size_t)(b * SEQ + s) * N_QKV + N_A + 1024 + h * HD + 2 * lane;
            const unsigned kw = *(const unsigned*)kp, vw = *(const unsigned*)(kp + 1024);
            c += LOGF[(size_t)(b * SEQ + s) * 8 + h];
            const float sc = wave_sum(q0 * bf_lo(kw) + q1 * bf_hi(kw)) - c * LOG2E;
            const float mn = fmaxf(m, sc), al = fast_exp2(m - mn), p = fast_exp2(sc - mn);
            l = l * al + p; o0 = o0 * al + p * bf_lo(vw); o1 = o1 * al + p * bf_hi(vw); m = mn;
        }
        const float il = 1.0f / l;
        *(unsigned*)(YAB + (size_t)(b * SEQ + t) * YAB_W + 512 + h * HD + 2 * lane) = cvt_pk_bf16(o0 * il, o1 * il);
    }
    for (int i = gw; i < M * 4; i += ngw) {
        const int row = i >> 2, hs = i & 3, t = row & 2047;
        float m = -1e30f, l = 0.f, o0 = 0.f, o1 = 0.f;
        for (int g = 0; g < 3; ++g) {
            const int dil = g == 0 ? 1 : (g == 1 ? 4 : 16), head = g * 4 + hs;
            const unsigned qw = *(const unsigned*)(QKV + (size_t)row * N_QKV + head * HD + 2 * lane);
            const float q0 = bf_lo(qw), q1 = bf_hi(qw);
            for (int j = 0; j <= 128; ++j) {
                const int s = t - j * dil; if (s < 0) break;
                const bf16_t* kp = QKV + (size_t)(row - j * dil) * N_QKV + 1536 + head * HD + 2 * lane;
                const unsigned kw = *(const unsigned*)kp, vw = *(const unsigned*)(kp + 1536);
                const float sc = wave_sum(q0 * bf_lo(kw) + q1 * bf_hi(kw)) + TAB[head * 132 + j];
                const float mn = fmaxf(m, sc), al = fast_exp2(m - mn), p = fast_exp2(sc - mn);
                l = l * al + p; o0 = o0 * al + p * bf_lo(vw); o1 = o1 * al + p * bf_hi(vw); m = mn;
            }
        }
        const float il = 1.0f / l;
        *(unsigned*)(YAB + (size_t)row * YAB_W + hs * HD + 2 * lane) = cvt_pk_bf16(o0 * il, o1 * il);
    }
}


namespace att {
typedef short s16x4 __attribute__((ext_vector_type(4)));
typedef float f32x16 __attribute__((ext_vector_type(16)));
constexpr int KVBLK = 64, SHM_V = 16384, SHM_K = 16384;
constexpr int SUPER = 65536, OFF_K = 0, OFF_V = 32768, OFF_BIAS = HALO_OFF, OFF_WS = HALO_OFF + 8192;
static_assert(2 * SUPER <= LDSCTL_OFF && OFF_WS + NWAVES * 64 * 4 <= LDS_BYTES && (HALO_OFF % 16) == 0, "attention LDS map");
constexpr float THR = 8.f;
constexpr int NUNITS = 192;
#define KSWZ(row, colB) ((row) * 256 + ((colB) ^ (((row) & 7) << 4)))
#define SBAR() __builtin_amdgcn_sched_barrier(0)
__device__ __forceinline__ int v_st(int k, int c) { const int kk = (k & ~0xC) | ((k & 4) << 1) | ((k & 8) >> 1); return ((kk >> 3) * 4 + (c >> 5)) * 512 + ((kk & 7) * 32 + (c & 31)) * 2; }
__device__ __forceinline__ int v_rd_base(int lane) { return ((lane & 3) << 3) | (((lane >> 2) & 3) << 6) | (((lane >> 4) & 1) << 5) | (((lane >> 5) & 1) << 8); }
constexpr int v_rd_off(int d0, int ks, int half) { return d0 * 512 + ks * 4096 + half * 2048; }
__device__ __forceinline__ int crow(int r, int hi) { return (r & 3) + 8 * (r >> 2) + 4 * hi; }

__device__ __forceinline__ void softmax_tile(f32x16& p0, f32x16& p1, float& m_reg, float& l_reg, float& alpha, bf16x8& pa0, bf16x8& pa1, bf16x8& pa2, bf16x8& pa3) {
    float pmax = p0[0];
#pragma unroll
    for (int r = 1; r < 16; ++r) pmax = fmaxf(pmax, p0[r]);
#pragma unroll
    for (int r = 0; r < 16; ++r) pmax = fmaxf(pmax, p1[r]);
    { auto rr = __builtin_amdgcn_permlane32_swap(__float_as_uint(pmax), __float_as_uint(pmax), false, false);
      pmax = fmaxf(__uint_as_float(rr[0]), __uint_as_float(rr[1])); }
    float mn;
    if (__builtin_expect(__all((pmax - m_reg) <= THR), 1)) { mn = m_reg; alpha = 1.f; }
    else { mn = fmaxf(m_reg, pmax); alpha = __builtin_amdgcn_exp2f(m_reg - mn); m_reg = mn; }
#pragma unroll
    for (int r = 0; r < 16; ++r) p0[r] = __builtin_amdgcn_exp2f(p0[r] - mn);
#pragma unroll
    for (int r = 0; r < 16; ++r) p1[r] = __builtin_amdgcn_exp2f(p1[r] - mn);
    float ps = 0;
#pragma unroll
    for (int r = 0; r < 16; ++r) ps += p0[r];
#pragma unroll
    for (int r = 0; r < 16; ++r) ps += p1[r];
    { auto rr = __builtin_amdgcn_permlane32_swap(__float_as_uint(ps), __float_as_uint(ps), false, false);
      ps = __uint_as_float(rr[0]) + __uint_as_float(rr[1]); }
    l_reg = l_reg * alpha + ps;
#define PK4(P, B_, OUT) do { unsigned a0 = cvt_pk_bf16(P[B_+0], P[B_+1]), a1 = cvt_pk_bf16(P[B_+2], P[B_+3]);                          \
        unsigned b0 = cvt_pk_bf16(P[B_+4], P[B_+5]), b1 = cvt_pk_bf16(P[B_+6], P[B_+7]);                                             \
        auto r0 = __builtin_amdgcn_permlane32_swap(a0, b0, false, false); auto r1 = __builtin_amdgcn_permlane32_swap(a1, b1, false, false); \
        u32x4 w = {r0[0], r1[0], r0[1], r1[1]}; OUT = *reinterpret_cast<bf16x8*>(&w); } while (0)
    PK4(p0, 0, pa0); PK4(p0, 8, pa1); PK4(p1, 0, pa2); PK4(p1, 8, pa3);
#undef PK4
}
__device__ __forceinline__ void qkt(f32x16& p0, f32x16& p1, LAS unsigned char* kbase, int r32, int hi, const bf16x8 (&qr)[8]) {
    int ka[4];
#pragma unroll
    for (int dd = 0; dd < 4; ++dd) ka[dd] = (int)(uintptr_t)(kbase + KSWZ(r32, (dd * 16 + hi * 8) * 2));
    bf16x8 f0a, f0b, f1a, f1b;
#define KRD(A, B, d0) asm volatile("ds_read_b128 %0, %2 offset:%3\n\tds_read_b128 %1, %2 offset:%4" : "=&v"(A), "=&v"(B) : "v"(ka[(d0) & 3]), "i"(((d0) >> 2) * 128), "i"(((d0) >> 2) * 128 + 32 * 256) : "memory")
#define KMM(A, B, d0) do { p0 = __builtin_amdgcn_mfma_f32_32x32x16_bf16(A, qr[d0], p0, 0, 0, 0); p1 = __builtin_amdgcn_mfma_f32_32x32x16_bf16(B, qr[d0], p1, 0, 0, 0); } while (0)
#define KW(n) do { asm volatile("s_waitcnt lgkmcnt(" #n ")" ::: "memory"); SBAR(); } while (0)
    KRD(f0a, f0b, 0);
    __builtin_amdgcn_s_setprio(1);
    KRD(f1a, f1b, 1); KW(2); KMM(f0a, f0b, 0); SBAR();
    KRD(f0a, f0b, 2); KW(2); KMM(f1a, f1b, 1); SBAR();
    KRD(f1a, f1b, 3); KW(2); KMM(f0a, f0b, 2); SBAR();
    KRD(f0a, f0b, 4); KW(2); KMM(f1a, f1b, 3); SBAR();
    KRD(f1a, f1b, 5); KW(2); KMM(f0a, f0b, 4); SBAR();
    KRD(f0a, f0b, 6); KW(2); KMM(f1a, f1b, 5); SBAR();
    KRD(f1a, f1b, 7); KW(2); KMM(f0a, f0b, 6); SBAR();
    KW(0); KMM(f1a, f1b, 7);
    __builtin_amdgcn_s_setprio(0);
#undef KRD
#undef KMM
#undef KW
}
__device__ __forceinline__ void pv_tile(f32x16 (&o)[4], int vb0, bf16x8 pa0, bf16x8 pa1, bf16x8 pa2, bf16x8 pa3) {
#define TRRD(dst, off) asm volatile("ds_read_b64_tr_b16 %0, %1 offset:%2" : "=&v"(dst) : "v"(vb0), "i"(off) : "memory")
#define TRSET(S, d0) do { constexpr int b_ = v_rd_off(d0, 0, 0);   \
        TRRD(S##l0, b_); TRRD(S##h0, b_ + 2048); TRRD(S##l1, b_ + 4096); TRRD(S##h1, b_ + 6144); TRRD(S##l2, b_ + 8192); TRRD(S##h2, b_ + 10240); TRRD(S##l3, b_ + 12288); TRRD(S##h3, b_ + 14336); } while (0)
#define PVMM(S, d0) do {   \
        o[d0] = __builtin_amdgcn_mfma_f32_32x32x16_bf16(pa0, (bf16x8){S##l0[0], S##l0[1], S##l0[2], S##l0[3], S##h0[0], S##h0[1], S##h0[2], S##h0[3]}, o[d0], 0, 0, 0);   \
        o[d0] = __builtin_amdgcn_mfma_f32_32x32x16_bf16(pa1, (bf16x8){S##l1[0], S##l1[1], S##l1[2], S##l1[3], S##h1[0], S##h1[1], S##h1[2], S##h1[3]}, o[d0], 0, 0, 0);   \
        o[d0] = __builtin_amdgcn_mfma_f32_32x32x16_bf16(pa2, (bf16x8){S##l2[0], S##l2[1], S##l2[2], S##l2[3], S##h2[0], S##h2[1], S##h2[2], S##h2[3]}, o[d0], 0, 0, 0);   \
        o[d0] = __builtin_amdgcn_mfma_f32_32x32x16_bf16(pa3, (bf16x8){S##l3[0], S##l3[1], S##l3[2], S##l3[3], S##h3[0], S##h3[1], S##h3[2], S##h3[3]}, o[d0], 0, 0, 0); } while (0)
#define PVW(n) do { asm volatile("s_waitcnt lgkmcnt(" #n ")" ::: "memory"); SBAR(); } while (0)
    s16x4 al0, al1, al2, al3, ah0, ah1, ah2, ah3, bl0, bl1, bl2, bl3, bh0, bh1, bh2, bh3;
    TRSET(a, 0);
    __builtin_amdgcn_s_setprio(1);
    TRSET(b, 1); PVW(8); PVMM(a, 0); SBAR();
    TRSET(a, 2); PVW(8); PVMM(b, 1); SBAR();
    TRSET(b, 3); PVW(8); PVMM(a, 2); SBAR();
    PVW(0); PVMM(b, 3);
    __builtin_amdgcn_s_setprio(0);
#undef TRSET
#undef PVMM
#undef PVW
#undef TRRD
}

__device__ __forceinline__ void attn_phase(LAS unsigned char* lds, const bf16_t* QKV, const float* LOGF, const float* TAB, bf16_t* YAB, bf16_t* OG, float* ML, unsigned* qctr0, int wv, int cid) {
    unsigned* qctr = qctr0 + 16 * (cid & 7); const int bq = cid & 7;
    const int tid = opaque_tid(wv), wid = __builtin_amdgcn_readfirstlane(tid >> 6), lane = tid & 63, r32 = lane & 31, hi = lane >> 5;
    volatile LAS unsigned* misc = (volatile LAS unsigned*)(lds + MISC_OFF);
    LAS float* wsf = (LAS float*)(lds + OFF_WS) + wid * 64;
    LAS float* biasf = (LAS float*)(lds + OFF_BIAS);
    const float NEG = -__builtin_inff();
    if (tid == 0) misc[0] = __hip_atomic_fetch_add(qctr, 1u, __ATOMIC_RELAXED, __HIP_MEMORY_SCOPE_AGENT);
    int upar = 0;
    for (;;) {
        __syncthreads();
        const int u = __builtin_amdgcn_readfirstlane((int)misc[upar]); upar ^= 1;
        if (u >= NUNITS) break;
        unsigned unext = 0;
        int mode, q0, nwa, kt_lo, kt_hi; size_t pitch, opitch, mlpitch = 0; const bf16_t *Qp, *Kp, *Vp; bf16_t* Op; float* MLp = nullptr; const float* lfp = nullptr; const float* tabp = nullptr;
        if (u < 64) {
            const int qb = 7 - (u >> 3), b = bq, h = u & 7;
            mode = 0; q0 = 256 * qb; nwa = 8; kt_lo = 0; kt_hi = 4 * (qb + 1); pitch = N_QKV; opitch = YAB_W;
            Kp = QKV + (size_t)(b * SEQ) * N_QKV + N_A + 1024 + h * HD; Vp = Kp + 1024; Qp = QKV + (size_t)(b * SEQ + q0) * N_QKV + N_A + h * HD;
            Op = YAB + (size_t)(b * SEQ + q0) * YAB_W + 512 + h * HD;
            lfp = LOGF + (size_t)(b * SEQ + 4 * tid) * 8 + h;
        } else {
            int g, b, hh, r, qb, dil;
            b = bq;
            if (u < 96) { const int v = u - 64; g = 0; dil = 1; qb = v >> 2; hh = v & 3; r = 0; nwa = 8; kt_lo = 4 * qb - 2; kt_hi = 4 * qb + 4; }
            else if (u < 128) { const int v = u - 96; g = 1; dil = 4; qb = v >> 4; hh = (v >> 2) & 3; r = v & 3; nwa = 8; kt_lo = 4 * qb - 2; kt_hi = 4 * qb + 4; }
            else { const int v = u - 128; g = 2; dil = 16; qb = 0; hh = v >> 4; r = v & 15; nwa = 4; kt_lo = 0; kt_hi = 2; }
            if (kt_lo < 0) kt_lo = 0;
            mode = 1; q0 = 256 * qb; const int head = g * 4 + hh; const size_t tok0 = (size_t)b * SEQ + r;
            pitch = (size_t)N_QKV * dil; opitch = (size_t)512 * dil; mlpitch = (size_t)8 * dil;
            Kp = QKV + tok0 * N_QKV + 1536 + head * HD; Vp = Kp + 1536; Qp = QKV + (tok0 + (size_t)q0 * dil) * N_QKV + head * HD;
            Op = OG + ((size_t)g * M + tok0 + (size_t)q0 * dil) * 512 + hh * HD;
            MLp = ML + (((size_t)g * M + tok0 + (size_t)q0 * dil) * 4 + hh) * 2;
            tabp = TAB + head * 132;
        }
        const bool wact = wid < nwa;
        const int qw = q0 + wid * 32;
        bf16x8 qr[8];
        if (wact) {
#pragma unroll
            for (int d0 = 0; d0 < 8; ++d0) qr[d0] = *(const bf16x8*)(Qp + (size_t)(wid * 32 + r32) * pitch + d0 * 16 + hi * 8);
        } else {
#pragma unroll
            for (int d0 = 0; d0 < 8; ++d0) qr[d0] = (bf16x8){0, 0, 0, 0, 0, 0, 0, 0};
        }
        float m_reg = -1e30f, l_reg = 0.f; f32x16 o[4];
#pragma unroll
        for (int d = 0; d < 4; ++d)
#pragma unroll
            for (int r = 0; r < 16; ++r) o[d][r] = 0.f;
        unsigned kof[4], vof[4];
        { int ln = lane; asm volatile("" : "+v"(ln));
#pragma unroll
          for (int i = 0; i < 4; ++i) {
              const int b = wid * 4 + i, j = b >> 4, blk = b & 15;
              const int row = blk * 4 + (ln >> 4), kkey = j * 64 + row, kcol = ((ln & 15) ^ (row & 7)) * 8;
              const int sub = blk * 2 + (ln >> 5), kk = (sub >> 2) * 8 + ((ln & 31) >> 2), k = (kk & ~0xC) | ((kk & 4) << 1) | ((kk & 8) >> 1);
              const int vkey = j * 64 + k, vcol = (sub & 3) * 32 + (ln & 3) * 8;
              kof[i] = (unsigned)(((size_t)kkey * pitch + kcol) * 2); vof[i] = (unsigned)(((size_t)vkey * pitch + vcol) * 2); } }
        const int s_lo = kt_lo >> 1, s_hi = kt_hi >> 1;
#define KVDMA(s_, bf_) do { const char* kg_ = (const char*)(Kp + (size_t)((s_) * 128) * pitch); const char* vg_ = (const char*)(Vp + (size_t)((s_) * 128) * pitch); \
        _Pragma("unroll") for (int i_ = 0; i_ < 4; ++i_) { \
            __builtin_amdgcn_global_load_lds((const unsigned*)(kg_ + kof[i_]), (LAS unsigned*)(lds + (bf_) * SUPER + OFF_K + (wid * 4 + i_) * 1024), 16, 0, 0); \
            __builtin_amdgcn_global_load_lds((const unsigned*)(vg_ + vof[i_]), (LAS unsigned*)(lds + (bf_) * SUPER + OFF_V + (wid * 4 + i_) * 1024), 16, 0, 0); } } while (0)
        KVDMA(s_lo, 0);
        if (mode == 0) {
            float a0 = 0.f, a1 = 0.f, a2 = 0.f, a3 = 0.f;
            if (4 * tid < 64 * kt_hi) { a0 = lfp[0]; a1 = lfp[8]; a2 = lfp[16]; a3 = lfp[24]; }
            a1 += a0; a2 += a1; a3 += a2;
            float inc = a3;
#pragma unroll
            for (int o_ = 1; o_ < 64; o_ <<= 1) { const float t_ = __shfl_up(inc, o_); if (lane >= o_) inc += t_; }
            if (lane == 63) wsf[0] = inc;
            __syncthreads();
            float base = inc - a3;
            for (int w_ = 0; w_ < wid; ++w_) base += ((LAS float*)(lds + OFF_WS))[w_ * 64];
            *(LAS f32x4*)(biasf + 4 * tid) = (f32x4){-(base + a0) * LOG2E, -(base + a1) * LOG2E, -(base + a2) * LOG2E, -(base + a3) * LOG2E};
        } else {
            if (tid < 384) { const int d = tid - 127; biasf[tid] = (d >= 0 && d <= 128) ? tabp[d] : NEG; }
        }
        asm volatile("s_waitcnt vmcnt(0)" ::: "memory");
        __syncthreads();
        for (int sp = s_lo; sp < s_hi; ++sp) {
            const int buf = (sp - s_lo) & 1;
            if (sp == s_lo && tid == 0) unext = __hip_atomic_fetch_add(qctr, 1u, __ATOMIC_RELAXED, __HIP_MEMORY_SCOPE_AGENT);
            if (sp + 1 < s_hi) KVDMA(sp + 1, buf ^ 1);
            for (int j2 = 0; j2 < 2; ++j2) {
                const int t = 2 * sp + j2, kb = t * KVBLK;
                const bool act = wact && (kb <= qw + 31) && (mode == 0 || kb + 63 >= qw - 128);
                if (act) {
                    f32x16 p0, p1;
                    if (mode == 0) {
                        const LAS float* cb = biasf + kb + 4 * hi;
#pragma unroll
                        for (int q4 = 0; q4 < 4; ++q4) { const f32x4 x0 = *(const LAS f32x4*)(cb + 8 * q4), x1 = *(const LAS f32x4*)(cb + 32 + 8 * q4);
#pragma unroll
                            for (int e = 0; e < 4; ++e) { p0[4 * q4 + e] = x0[e]; p1[4 * q4 + e] = x1[e]; } }
                    } else {
                        const LAS float* tb = biasf + (qw + r32 - kb - 4 * hi + 68);
#pragma unroll
                        for (int r = 0; r < 16; ++r) { const int c = (r & 3) + 8 * (r >> 2); p0[r] = tb[27 - c + 32]; p1[r] = tb[27 - c]; }
                    }
                    qkt(p0, p1, lds + buf * SUPER + OFF_K + j2 * SHM_K, r32, hi, qr);
                    if (mode == 0 && kb + 63 > qw) {
                        const int dq = qw + r32 - kb - 4 * hi;
#pragma unroll
                        for (int r = 0; r < 16; ++r) { const int c = (r & 3) + 8 * (r >> 2); if (dq - c < 0) p0[r] = NEG; if (dq - c - 32 < 0) p1[r] = NEG; }
                    }
                    float alpha; bf16x8 pa0, pa1, pa2, pa3;
                    softmax_tile(p0, p1, m_reg, l_reg, alpha, pa0, pa1, pa2, pa3);
                    if (__any(alpha < 1.f)) { if (hi == 0) wsf[r32] = alpha; asm volatile("s_waitcnt lgkmcnt(0)" ::: "memory");
#pragma unroll
                        for (int r = 0; r < 16; ++r) { const float a_ = wsf[crow(r, hi)];
#pragma unroll
                            for (int d = 0; d < 4; ++d) o[d][r] *= a_; } }
                    pv_tile(o, (int)(uintptr_t)(lds + buf * SUPER + OFF_V + j2 * SHM_V) + v_rd_base(lane), pa0, pa1, pa2, pa3);
                }
            }
            if (sp == s_lo && tid == 0) misc[upar] = unext;
            asm volatile("s_waitcnt vmcnt(0)" ::: "memory");
            __syncthreads();
        }
#undef KVDMA
        if (wact) {
            if (hi == 0) wsf[32 + r32] = l_reg; asm volatile("s_waitcnt lgkmcnt(0)" ::: "memory");
            LAS unsigned char* stg = lds + wid * 8192;
#pragma unroll
            for (int r = 0; r < 16; ++r) { const float il = __builtin_amdgcn_rcpf(wsf[32 + crow(r, hi)]);
#pragma unroll
                for (int d = 0; d < 4; ++d) *(LAS unsigned short*)(stg + crow(r, hi) * 256 + (d * 32 + r32) * 2) = (unsigned short)(cvt_pk_bf16(o[d][r] * il, 0.f) & 0xffffu); }
            asm volatile("s_waitcnt lgkmcnt(0)" ::: "memory");
#pragma unroll
            for (int i = 0; i < 8; ++i) { const int row = (lane >> 4) + 4 * i, ch = lane & 15;
                const u32x4 w = *(const LAS u32x4*)(stg + row * 256 + ch * 16);
                *(u32x4*)(Op + (size_t)(wid * 32 + row) * opitch + ch * 8) = w; }
            if (mode == 1 && hi == 0) *(f32x2*)(MLp + (size_t)(wid * 32 + r32) * mlpitch) = (f32x2){m_reg, l_reg};
        }
    }
}
#undef KSWZ
#undef SBAR
}

__device__ __forceinline__ void merge_phase(const bf16_t* OG, const float* ML, bf16_t* YAB, int wv, int cid) {
    const int gt = (cid >> 3) * (NWAVES * 64) + opaque_tid(wv), NT = ((int)gridDim.x >> 3) * NWAVES * 64;
    for (int it = (cid & 7) * (SEQ * 64) + gt; it < ((cid & 7) + 1) * (SEQ * 64); it += NT) {
        const int row = it >> 6, hs = (it >> 4) & 3, c0 = (it & 15) * 8;
        f32x2 ml[3]; u32x4 ov[3];
#pragma unroll
        for (int g = 0; g < 3; ++g) { ml[g] = *(const f32x2*)(ML + (((size_t)g * M + row) * 4 + hs) * 2); ov[g] = *(const u32x4*)(OG + ((size_t)g * M + row) * 512 + hs * HD + c0); }
        const float mx = fmaxf(fmaxf(ml[0][0], ml[1][0]), ml[2][0]);
        float w[3]; float ws_ = 0.f;
#pragma unroll
        for (int g = 0; g < 3; ++g) { w[g] = ml[g][1] * fast_exp2(ml[g][0] - mx); ws_ += w[g]; }
        const float inv = 1.0f / ws_;
        float y[8];
#pragma unroll
        for (int e = 0; e < 4; ++e) {
            y[2 * e] = (w[0] * bf_lo(ov[0][e]) + w[1] * bf_lo(ov[1][e]) + w[2] * bf_lo(ov[2][e])) * inv;
            y[2 * e + 1] = (w[0] * bf_hi(ov[0][e]) + w[1] * bf_hi(ov[1][e]) + w[2] * bf_hi(ov[2][e])) * inv;
        }
        store_bf16x8(YAB + (size_t)row * YAB_W + hs * HD + c0, y);
    }
}

__device__ __forceinline__ void norm_phase(const bf16_t* src, bf16_t* XB, const float* gpost, const float* gpre, bf16_t* H, float* fout, unsigned char* H8, int wv, int cid) {
    const int tid = opaque_tid(wv), lane = tid & 63, gw = (cid >> 3) * NWAVES + __builtin_amdgcn_readfirstlane(tid >> 6), ngw = ((int)gridDim.x >> 3) * NWAVES, M0 = (cid & 7) * SEQ, M1 = M0 + SEQ;
    f32x4 ga[8], gb[8];
#pragma unroll
    for (int j = 0; j < 8; ++j) { const int ix = 2 * (lane + 64 * (j >> 1)) + (j & 1); ga[j] = *((const f32x4*)gpost + ix); gb[j] = gpre ? *((const f32x4*)gpre + ix) : (f32x4){0.f, 0.f, 0.f, 0.f}; }
    u32x4 sv[4], nsv[4], xw[4], nxw[4];
    int m = M0 + gw;
    if (m < M1) {
#pragma unroll
        for (int c = 0; c < 4; ++c) { sv[c] = *((const u32x4*)(src + (size_t)m * DM) + lane + 64 * c); xw[c] = *((const u32x4*)(XB + (size_t)m * DM) + lane + 64 * c); }
    }
    for (; m < M1; m += ngw) {
        const int mn = m + ngw;
        if (mn < M1) {
#pragma unroll
            for (int c = 0; c < 4; ++c) { nsv[c] = *((const u32x4*)(src + (size_t)mn * DM) + lane + 64 * c); nxw[c] = *((const u32x4*)(XB + (size_t)mn * DM) + lane + 64 * c); }
        }
        f32x4 v[8], xv[8]; float s = 0.f;
#pragma unroll
        for (int j = 0; j < 8; ++j) { const unsigned w0 = sv[j >> 1][2 * (j & 1)], w1 = sv[j >> 1][2 * (j & 1) + 1]; v[j] = (f32x4){bf_lo(w0), bf_hi(w0), bf_lo(w1), bf_hi(w1)};
            s += (v[j][0] * v[j][0] + v[j][1] * v[j][1]) + (v[j][2] * v[j][2] + v[j][3] * v[j][3]); }
        const float r = 1.0f / sqrtf(wave_sum(s) * (1.0f / DM) + EPS);
        float s2 = 0.f;
#pragma unroll
        for (int j = 0; j < 8; ++j) { const unsigned w0 = xw[j >> 1][2 * (j & 1)], w1 = xw[j >> 1][2 * (j & 1) + 1];
            xv[j] = (f32x4){bf_lo(w0), bf_hi(w0), bf_lo(w1), bf_hi(w1)} + v[j] * r * ga[j];
            if (fout) *((f32x4*)(fout + (size_t)m * DM) + 2 * (lane + 64 * (j >> 1)) + (j & 1)) = xv[j];
            s2 += (xv[j][0] * xv[j][0] + xv[j][1] * xv[j][1]) + (xv[j][2] * xv[j][2] + xv[j][3] * xv[j][3]); }
        if (!fout) {
#pragma unroll
            for (int c = 0; c < 4; ++c) { u32x4 w; w.x = cvt_pk_bf16(xv[2 * c][0], xv[2 * c][1]); w.y = cvt_pk_bf16(xv[2 * c][2], xv[2 * c][3]); w.z = cvt_pk_bf16(xv[2 * c + 1][0], xv[2 * c + 1][1]); w.w = cvt_pk_bf16(xv[2 * c + 1][2], xv[2 * c + 1][3]);
                *((u32x4*)(XB + (size_t)m * DM) + lane + 64 * c) = w; }
        }
        if (gpre) {
            const float r2 = 1.0f / sqrtf(wave_sum(s2) * (1.0f / DM) + EPS);
#pragma unroll
            for (int c = 0; c < 4; ++c) { const f32x4 a = xv[2 * c] * r2 * gb[2 * c], b = xv[2 * c + 1] * r2 * gb[2 * c + 1];
                u32x4 w; w.x = cvt_pk_bf16(a[0], a[1]); w.y = cvt_pk_bf16(a[2], a[3]); w.z = cvt_pk_bf16(b[0], b[1]); w.w = cvt_pk_bf16(b[2], b[3]);
                *((u32x4*)(H + (size_t)m * DM) + lane + 64 * c) = w;
                if (H8) { u32x2 q; q.x = pk4_fp8(a[0] * H8_SCALE, a[1] * H8_SCALE, a[2] * H8_SCALE, a[3] * H8_SCALE); q.y = pk4_fp8(b[0] * H8_SCALE, b[1] * H8_SCALE, b[2] * H8_SCALE, b[3] * H8_SCALE);
                    *((u32x2*)(H8 + (size_t)m * DM) + lane + 64 * c) = q; } }
        }
#pragma unroll
        for (int c = 0; c < 4; ++c) { sv[c] = nsv[c]; xw[c] = nxw[c]; }
    }
}
constexpr int PH_PER_LAYER = 10, N_PHASES = 1 + DEPTH * PH_PER_LAYER;
struct Args { const float* in[15]; float* out; unsigned char* ws; int ph_lo, ph_hi; };
__global__ void __launch_bounds__(NWAVES * 64, 2) fwd(Args args) {
    extern __shared__ __attribute__((aligned(16))) unsigned char lds_raw[];
    LAS unsigned char* lds = (LAS unsigned char*)lds_raw;
    const int tid = threadIdx.x;
    const int wv = __builtin_amdgcn_readfirstlane(tid >> 6);
    unsigned char* ws = args.ws;
    Ptrs P;
    P.x = args.in[0]; P.rel_bias = args.in[1]; P.w_in = args.in[2]; P.b_f = args.in[3]; P.w_pa = args.in[4]; P.w_pb = args.in[5]; P.w_o = args.in[6]; P.w_up = args.in[7];
    P.conv_w = args.in[8]; P.conv_b = args.in[9]; P.w_down = args.in[10]; P.g_mix_pre = args.in[11]; P.g_mix_post = args.in[12]; P.g_ffn_pre = args.in[13]; P.g_ffn_post = args.in[14];
    P.out = args.out; P.ws = ws;
    for (int u = tid; u < (LDS_BYTES - LDSCTL_OFF) / 4; u += NWAVES * 64) ((LAS unsigned*)(lds + LDSCTL_OFF))[u] = 0u;
    __syncthreads();
    XcdBarrier bar; bar.bar = (unsigned*)(ws + WS_CTL) + CW_BAR; bar.x = 0; bar.st = nullptr;
#if ONE_LAUNCH
    bar = xcd_barrier_post((unsigned*)(ws + WS_CTL) + CW_BAR, (volatile LAS unsigned*)(lds + MISC_OFF) + 8);
#endif
    const int lo = args.ph_lo, hi = args.ph_hi;
#define IN(k) (lo <= (k) && (k) < hi)
#ifdef ONLY_SITE
#define SITE(s) ((s) == ONLY_SITE)
#else
#define SITE(s) true
#endif
#define SEAM(k) do { if (IN(k) && IN((k) + 1)) xcd_barrier(bar, wv, (k) > 0 && grp, NOREL && (((k) - 1) % PH_PER_LAYER) != 1); } while (0)
#define REP(s) for (int rep_ = 0; rep_ < ((s) == DUP_SITE ? 2 : 1); ++rep_)

    bf16_t* H = (bf16_t*)(ws + WS_H); bf16_t* XBr = (bf16_t*)(ws + WS_XB);
    bf16_t* QKV = (bf16_t*)(ws + WS_QKV); bf16_t* G = (bf16_t*)(ws + WS_G); float* LOGF = (float*)(ws + WS_LOGF); bf16_t* YAB = (bf16_t*)(ws + WS_YAB);
    bf16_t* PA = (bf16_t*)(ws + WS_PA); bf16_t* MERGED = (bf16_t*)(ws + WS_MERGED); bf16_t* MIX = (bf16_t*)(ws + WS_MIX);
    bf16_t* U = (bf16_t*)(ws + WS_U); bf16_t* ACTV = (bf16_t*)(ws + WS_ACTV); bf16_t* Y = (bf16_t*)(ws + WS_Y);
    const float* TAB = (const float*)(ws + WS_TAB);
    bf16_t* OGb = (bf16_t*)(ws + WS_OG); float* MLb = (float*)(ws + WS_ML);
    float* UHb = (float*)(ws + WS_UH); float* UFb = (float*)(ws + WS_UF);

    bool grp = false;
    if (SITE(0) && IN(0)) { REP(0) p0_prologue(P, lds, wv); SEAM(0); }
#if ONE_LAUNCH && BATCH_GROUPS
    grp = __builtin_amdgcn_readfirstlane((int)bar.st[2]) != 0;
    const int cid = grp ? (int)(__builtin_amdgcn_readfirstlane((int)bar.st[3]) * 8 + (int)bar.x) : (int)blockIdx.x;
#else
    const int cid = (int)blockIdx.x;
#endif
    unsigned* wrdy = (unsigned*)(ws + WS_CTL) + CW_WRDY;
#define LATE_CONV(kk) do { if (LATE_CONVERT && layer + 1 < DEPTH && ((cid & 7) >> 1) == (kk)) { \
        asm volatile("s_waitcnt vmcnt(0)" ::: "memory"); __syncthreads(); convert_share(P, lds, layer + 1, wv, cid); } } while (0)
#define LATE_SIG(kk) do { if (LATE_CONVERT && layer + 1 < DEPTH && opaque_tid(wv) == 0) (void)xb_add(wrdy + 16 * (layer + 1), 1u); } while (0)
    for (int layer = 0; layer < DEPTH; ++layer) {
        const int pb = 1 + layer * PH_PER_LAYER;
        if (LATE_CONVERT && layer > 0) {
            if (opaque_tid(wv) == 0) { XB_SPIN(xb_ld(wrdy + 16 * layer) < gridDim.x, bar.bar); __builtin_amdgcn_fence(__ATOMIC_ACQUIRE, "agent"); asm volatile("s_waitcnt vmcnt(0)" ::: "memory"); }
            __syncthreads();
        }
        if (SITE(1) && IN(pb + 0)) {
            { Gemm g{H, DM, (const bf16_t*)(ws + WS_WIN + layer * SZ_WIN), DM, M, N_QKV, DM};
              EpiInProj E{QKV, LOGF, P.b_f + layer * 8};
              REP(1) { flogit_phase(lds, H, (const bf16_t*)(ws + WS_WIN + layer * SZ_WIN) + (size_t)N_QKV * DM, E, wv, cid); run_gemm(lds, g, E, wv, cid); } }
            { Gemm g{(const bf16_t*)(ws + WS_H8), DM, (const bf16_t*)(ws + WS_WIN + layer * SZ_WIN + OFF_WG8), DM, M, N_G, DM};
              EpiGates E{G};
              REP(1) run_gemm<true>(lds, g, E, wv, cid, 1); }
            SEAM(pb + 0);
        }
#if FAST_ATTN
        if (SITE(2) && IN(pb + 1)) { if (LATE_CONVERT && layer + 1 < DEPTH) convert_share(P, lds, layer + 1, wv, cid);
            if (LATE_CONVERT && LATE0 && layer == 0) convert_share(P, lds, 0, wv, cid, cv::I_IN1 + cv::I_IN2, cv::PER_LAYER, CV_WGS);
            REP(2) att::attn_phase(lds, QKV, LOGF, TAB, YAB, OGb, MLb, (unsigned*)(ws + WS_CTL) + CW_Q + 128 * (layer + 4 * rep_), wv, cid); SEAM(pb + 1); LATE_SIG(1);
            if (LATE_CONVERT && LATE0 && layer == 0 && opaque_tid(wv) == 0) (void)xb_add(wrdy, 1u); }
        if (SITE(3) && IN(pb + 2)) { REP(3) merge_phase(OGb, MLb, YAB, wv, cid); SEAM(pb + 2); }
#else
        if (SITE(2) && IN(pb + 1)) { attn_naive(QKV, LOGF, TAB, YAB, wv); SEAM(pb + 1); }
        if (IN(pb + 2)) { SEAM(pb + 2); }
#endif
        if (LATE_CONVERT && LATE0 && layer == 0) {
            if (opaque_tid(wv) == 0) { XB_SPIN(xb_ld(wrdy) < gridDim.x, bar.bar); __builtin_amdgcn_fence(__ATOMIC_ACQUIRE, "agent"); asm volatile("s_waitcnt vmcnt(0)" ::: "memory"); }
            __syncthreads();
        }
        if (SITE(5) && IN(pb + 3)) {
            Gemm g{YAB, YAB_W, (const bf16_t*)(ws + WS_WPA + layer * SZ_WPAB), YAB_W, M, DM, YAB_W};
            EpiPaPb E{G, MERGED};
            REP(5) run_gemm(lds, g, E, wv, cid); SEAM(pb + 3);
        }
        if (SITE(6) && IN(pb + 4)) {
            Gemm g{MERGED, DM, (const bf16_t*)(ws + WS_WO + layer * SZ_WO), DM, M, DM, DM};
            EpiBf16 E{MIX, DM};
            REP(6) run_gemm(lds, g, E, wv, cid); SEAM(pb + 4);
        }
        if (SITE(7) && IN(pb + 5)) { norm_phase(MIX, XBr, P.g_mix_post + layer * DM, P.g_ffn_pre + layer * DM, H, nullptr, nullptr, wv, cid); SEAM(pb + 5); }
        if (SITE(8) && IN(pb + 6)) {
            Gemm g{H, DM, (const bf16_t*)(ws + WS_WUP + layer * SZ_WUP), DM, M, N_UP, DM};
            EpiConv E{P.conv_w + (size_t)layer * 3 * N_UP, P.conv_b + (size_t)layer * N_UP, ACTV, UHb, UFb};
            REP(8) run_gemm(lds, g, E, wv, cid); SEAM(pb + 6);
        }
#if !FIX_LOCAL
        if (SITE(9) && IN(pb + 7)) { REP(9) fixup_phase(UHb, UFb, P.conv_w + (size_t)layer * 3 * N_UP, P.conv_b + (size_t)layer * N_UP, ACTV, wv); SEAM(pb + 7); }
#endif
        if (SITE(10) && IN(pb + 8)) {
            Gemm g{ACTV, DFF, (const bf16_t*)(ws + WS_WDN + layer * SZ_WDN), DFF, M, DM, DFF};
            EpiBf16 E{Y, DM};
#if FIX_LOCAL
            fixup_local(UHb, UFb, P.conv_w + (size_t)layer * 3 * N_UP, P.conv_b + (size_t)layer * N_UP, ACTV, wv, cid);
#endif
            REP(10) run_gemm(lds, g, E, wv, cid); SEAM(pb + 8);
        }
        if (SITE(11) && IN(pb + 9)) {
            norm_phase(Y, XBr, P.g_ffn_post + layer * DM, layer + 1 < DEPTH ? P.g_mix_pre + (layer + 1) * DM : nullptr, H, layer + 1 < DEPTH ? nullptr : P.out, ws + WS_H8, wv, cid);
            SEAM(pb + 9);
        }
    }
#undef IN
#undef SEAM
#undef LATE_CONV
#undef LATE_SIG
}

extern "C" void kernel_launch(void* const* d_in, const int* in_sizes, int n_in, void* d_out, int out_size, void* d_ws, size_t ws_size, hipStream_t stream) {
    static int grid = 0;
    if (grid == 0) {
        if (n_in != 15 || out_size != M * DM || ws_size < WS_END) { fprintf(stderr, "kernel_launch: unexpected shapes (n_in %d out %d ws %zu need %zu)\n", n_in, out_size, ws_size, (size_t)WS_END); grid = -1; return; }
        int dev = 0, cus = 0, per_cu = 0;
        if (hipGetDevice(&dev) != hipSuccess || hipDeviceGetAttribute(&cus, hipDeviceAttributeMultiprocessorCount, dev) != hipSuccess) { grid = -1; return; }
        if (hipFuncSetAttribute((const void*)fwd, hipFuncAttributeMaxDynamicSharedMemorySize, LDS_BYTES) != hipSuccess) { fprintf(stderr, "kernel_launch: hipFuncSetAttribute failed\n"); grid = -1; return; }
        if (hipOccupancyMaxActiveBlocksPerMultiprocessor(&per_cu, (const void*)fwd, NWAVES * 64, LDS_BYTES) != hipSuccess || per_cu < 1) { fprintf(stderr, "kernel_launch: occupancy query says %d\n", per_cu); }
        (void)hipGetLastError();
        grid = cus;
    }
    if (grid < 0) return;
    (void)hipMemsetAsync((char*)d_ws + WS_CTL, 0, CTL_ZERO_BYTES, stream);
    Args a{};
    for (int i = 0; i < 15; ++i) a.in[i] = (const float*)d_in[i];
    a.out = (float*)d_out; a.ws = (unsigned char*)d_ws;
#if ONE_LAUNCH
    a.ph_lo = 0; a.ph_hi = N_PHASES;
    hipLaunchKernelGGL(fwd, dim3(grid), dim3(NWAVES * 64), LDS_BYTES, stream, a);
#else
    for (int p = 0; p < N_PHASES; ++p) { a.ph_lo = p; a.ph_hi = p + 1; hipLaunchKernelGGL(fwd, dim3(grid), dim3(NWAVES * 64), LDS_BYTES, stream, a); }
#endif
}
```
